# Optimizing an MI355X kernel written in HIP

```python
import jax, jax.numpy as jnp
from jax import lax
import numpy as np

D_MODEL = 2048
BATCH = 8
SEQ = 2048
DEPTH = 1

HEAD_DIM = 128
N_HEADS = D_MODEL // HEAD_DIM
N_HEADS_B = N_HEADS // 4
N_HEADS_A = N_HEADS - N_HEADS_B
DILATED_PAIRS = ((128, 1), (512, 4), (2048, 16))
N_GROUPS_A = len(DILATED_PAIRS)
HEADS_PER_GROUP_A = N_HEADS_A // N_GROUPS_A
GRID_W = 64
WIN_R = 8
WIN_C = 16
QKV_W = N_HEADS * HEAD_DIM
D_IN = 3 * QKV_W + 2 * D_MODEL
D_A_OUT = HEADS_PER_GROUP_A * HEAD_DIM
D_B_OUT = N_HEADS_B * HEAD_DIM
D_FF = 4 * D_MODEL
ROPE_THETA = 10000.0
EPS = 1e-6
NEG_INF = -1e30

kernel_name = "hybrid_dilated_neighbourhood_gated_encoder"


def rms_norm(x, g):
    x32 = x.astype(jnp.float32)
    y = x32 * lax.rsqrt(jnp.mean(x32 * x32, axis=-1, keepdims=True) + EPS)
    return (y * g.astype(jnp.float32)).astype(x.dtype)


def rope(x, seq_len):
    pos = jnp.arange(seq_len, dtype=jnp.float32)
    inv = ROPE_THETA ** (-jnp.arange(0, HEAD_DIM, 2, dtype=jnp.float32) / HEAD_DIM)
    ang = pos[:, None] * inv[None, :]
    cos = jnp.cos(ang)[None, :, None, :]
    sin = jnp.sin(ang)[None, :, None, :]
    x32 = x.astype(jnp.float32)
    x1, x2 = jnp.split(x32, 2, axis=-1)
    return jnp.concatenate([x1 * cos - x2 * sin, x2 * cos + x1 * sin], axis=-1).astype(x.dtype)


def dilated_window_attention(q, k, v, window, dil):
    B, S, H, E = q.shape
    half = window // (2 * dil)
    blk = half
    M = S // dil
    nb = -(-M // blk)
    Mp = nb * blk

    def to_sub(t):
        return t.reshape(B, M, dil, H, E).transpose(0, 2, 3, 1, 4)

    qs = jnp.pad(to_sub(q), ((0, 0), (0, 0), (0, 0), (0, Mp - M), (0, 0)))
    qs = qs.reshape(B, dil, H, nb, blk, E)
    pad_kv = ((0, 0), (0, 0), (0, 0), (half, Mp - M + half), (0, 0))
    ks = jnp.pad(to_sub(k), pad_kv)
    vs = jnp.pad(to_sub(v), pad_kv)
    kb_len = blk + 2 * half
    idx = (jnp.arange(nb) * blk)[:, None] + jnp.arange(kb_len)[None, :]
    kb = ks[:, :, :, idx]
    vb = vs[:, :, :, idx]
    kpos = idx - half
    qpos = (jnp.arange(nb) * blk)[:, None] + jnp.arange(blk)[None, :]
    valid = (kpos >= 0) & (kpos < M)
    mask = (jnp.abs(kpos[:, None, :] - qpos[:, :, None]) <= half) & valid[:, None, :]
    s = jnp.einsum('bdhnqe,bdhnke->bdhnqk', qs, kb,
                   preferred_element_type=jnp.float32) * (E ** -0.5)
    s = jnp.where(mask, s, NEG_INF)
    lse = jax.nn.logsumexp(s, axis=-1)
    p = jnp.exp(s - lse[..., None]).astype(v.dtype)
    o = jnp.einsum('bdhnqk,bdhnke->bdhnqe', p, vb)
    o = o.reshape(B, dil, H, Mp, E)[:, :, :, :M].transpose(0, 3, 1, 2, 4).reshape(B, S, H, E)
    lse = lse.reshape(B, dil, H, Mp)[..., :M].transpose(0, 3, 1, 2).reshape(B, S, H)
    return o, lse


def neighbourhood_attention(q, k, v, rpb):
    B, S, H, E = q.shape
    rows = S // GRID_W
    kr = min(WIN_R, rows)
    kc = WIN_C

    def to_grid(t):
        return t.reshape(B, rows, GRID_W, H, E).transpose(0, 3, 1, 2, 4)

    qg, kg, vg = to_grid(q), to_grid(k), to_grid(v)
    r = jnp.arange(rows)
    row_idx = jnp.clip(r - kr // 2, 0, rows - kr)[:, None] + jnp.arange(kr)[None, :]
    kb = kg[:, :, row_idx]
    vb = vg[:, :, row_idx]
    c = jnp.arange(GRID_W)
    col_start = jnp.clip(c - kc // 2, 0, GRID_W - kc)
    col_mask = (c[None, :] >= col_start[:, None]) & (c[None, :] < col_start[:, None] + kc)
    dr = row_idx - r[:, None] + (WIN_R - 1)
    dc = jnp.clip(c[None, :] - c[:, None], -(kc - 1), kc - 1) + (WIN_C - 1)
    bias = rpb[:, dr[:, None, :, None], dc[None, :, None, :]]
    s = jnp.einsum('bhrqe,bhrjke->bhrqjk', qg, kb,
                   preferred_element_type=jnp.float32) * (E ** -0.5)
    s = s + bias.astype(jnp.float32)[None]
    s = jnp.where(col_mask[:, None, :], s, NEG_INF)
    p = jax.nn.softmax(s.reshape(B, H, rows, GRID_W, kr * GRID_W), axis=-1)
    p = p.reshape(s.shape).astype(v.dtype)
    o = jnp.einsum('bhrqjk,bhrjke->bhrqe', p, vb)
    return o.transpose(0, 2, 3, 1, 4).reshape(B, S, H, E)


def setup_inputs(seed: int = 0) -> dict:
    key = jax.random.key(seed)
    ks = jax.random.split(key, 16)
    f32 = jnp.float32

    def nrm(k, shape, scale):
        return jax.random.normal(k, shape, f32) * scale

    return {
        "x": nrm(ks[0], (BATCH, SEQ, D_MODEL), 1.0),
        "norm_mix": 1.0 + nrm(ks[1], (DEPTH, D_MODEL), 0.05),
        "w_in": nrm(ks[2], (DEPTH, D_MODEL, D_IN), D_MODEL ** -0.5),
        "b_gate": nrm(ks[3], (DEPTH, 2 * D_MODEL), 0.1),
        "q_norm_a": 1.0 + nrm(ks[4], (DEPTH, HEAD_DIM), 0.05),
        "k_norm_a": 1.0 + nrm(ks[5], (DEPTH, HEAD_DIM), 0.05),
        "q_norm_b": 1.0 + nrm(ks[6], (DEPTH, HEAD_DIM), 0.05),
        "k_norm_b": 1.0 + nrm(ks[7], (DEPTH, HEAD_DIM), 0.05),
        "rpb_b": nrm(ks[8], (DEPTH, N_HEADS_B, 2 * WIN_R - 1, 2 * WIN_C - 1), 0.1),
        "w_proj_a": nrm(ks[9], (DEPTH, D_A_OUT, D_MODEL), D_A_OUT ** -0.5),
        "w_proj_b": nrm(ks[10], (DEPTH, D_B_OUT, D_MODEL), D_B_OUT ** -0.5),
        "w_out": nrm(ks[11], (DEPTH, D_MODEL, D_MODEL), D_MODEL ** -0.5),
        "norm_ffn": 1.0 + nrm(ks[12], (DEPTH, D_MODEL), 0.05),
        "w_up": nrm(ks[13], (DEPTH, D_MODEL, D_FF), D_MODEL ** -0.5),
        "w_down": nrm(ks[14], (DEPTH, D_FF, D_MODEL), D_FF ** -0.5),
    }


def reference(x, norm_mix, w_in, b_gate, q_norm_a, k_norm_a, q_norm_b, k_norm_b, rpb_b,
              w_proj_a, w_proj_b, w_out, norm_ffn, w_up, w_down):
    B, S, _ = x.shape
    h = x
    for l in range(DEPTH):
        xn = rms_norm(h, norm_mix[l])
        proj = xn @ w_in[l]
        q, k, v, gate = jnp.split(proj, [QKV_W, 2 * QKV_W, 3 * QKV_W], axis=-1)
        q = q.reshape(B, S, N_HEADS, HEAD_DIM)
        k = k.reshape(B, S, N_HEADS, HEAD_DIM)
        v = v.reshape(B, S, N_HEADS, HEAD_DIM)

        qa = rope(rms_norm(q[:, :, :N_HEADS_A], q_norm_a[l]), S)
        ka = rope(rms_norm(k[:, :, :N_HEADS_A], k_norm_a[l]), S)
        va = v[:, :, :N_HEADS_A]
        outs, lses = [], []
        for g, (win, dil) in enumerate(DILATED_PAIRS):
            sl = slice(g * HEADS_PER_GROUP_A, (g + 1) * HEADS_PER_GROUP_A)
            o_g, lse_g = dilated_window_attention(qa[:, :, sl], ka[:, :, sl], va[:, :, sl], win, dil)
            outs.append(o_g)
            lses.append(lse_g)
        wts = jax.nn.softmax(jnp.stack(lses, axis=0), axis=0)
        oa = jnp.einsum('gbsh,gbshe->bshe', wts,
                        jnp.stack(outs, axis=0).astype(jnp.float32)).astype(x.dtype)

        qb = rms_norm(q[:, :, N_HEADS_A:], q_norm_b[l])
        kb = rms_norm(k[:, :, N_HEADS_A:], k_norm_b[l])
        ob = neighbourhood_attention(qb, kb, v[:, :, N_HEADS_A:], rpb_b[l])

        ya = oa.reshape(B, S, D_A_OUT) @ w_proj_a[l]
        yb = ob.reshape(B, S, D_B_OUT) @ w_proj_b[l]
        ga, gb = jnp.split(jax.nn.sigmoid((gate + b_gate[l]).astype(jnp.float32)), 2, axis=-1)
        mixed = (ga * ya + gb * yb).astype(x.dtype)
        h = h + mixed @ w_out[l]

        hn = rms_norm(h, norm_ffn[l])
        u = jax.nn.relu(hn @ w_up[l])
        h = h + (u * u) @ w_down[l]
    return h
```

```cpp
#include <hip/hip_runtime.h>
#include <hip/hip_cooperative_groups.h>
#include <cstdio>
#include <cstdint>
namespace cg = cooperative_groups;
#ifndef MK_MULTI
#define MK_MULTI 0
#endif
namespace pg8 {
#define PG8_LAS __attribute__((address_space(3)))
typedef unsigned short bf16_t;
typedef short bf16x8 __attribute__((ext_vector_type(8)));
typedef float f32x4 __attribute__((ext_vector_type(4)));
typedef unsigned u32x4 __attribute__((ext_vector_type(4)));
typedef int i32x8 __attribute__((ext_vector_type(8)));
constexpr int BM = 256, BK = 64, HALF = 128, HTB = HALF * BK * 2  , STAGE_BYTES = 8 * HTB, NXCD = 8, WGM = 2;

__host__ __device__ __forceinline__ int lds_byte(int r, int c) { const int st = (r >> 4) * 2 + (c >> 5), rr = r & 15, cc = c & 31, ob = rr * 64 + cc * 2; return st * 1024 + (ob ^ (((ob >> 9) & 1) << 5)); }
__host__ __device__ __forceinline__ void stage_rc(int b, int& R, int& C) { const int st = b / 1024, sb = b % 1024, swz = sb ^ (((sb >> 9) & 1) << 5); R = (st >> 1) * 16 + swz / 64; C = (st & 1) * 32 + (swz % 64) / 2; }
__host__ __device__ __forceinline__ int perm32(int rho) { const int n = rho >> 4, i = rho & 15; return 8 * (i >> 2) + 4 * n + (i & 3); }

struct Unit { int pm, pn, idx; };
struct Gemm { const bf16_t* A; const bf16_t* Bt; int M, N, K; size_t a_extra; };

struct StaticOrder {
    int nM, nN, nwg, G, c, dup;
    __host__ __device__ void init(int M, int N, int G_, int c_, int dup_ = 0) { nM = M / BM; nN = N / BM; nwg = nM * nN; G = G_; c = c_; dup = dup_; }
    __host__ __device__ bool next(int i, Unit& u) const {
        const long L = (long)(i >> dup) * G + c; if (L >= nwg) return false;
        int wgid = (int)L; { const int q = nwg / NXCD, r = nwg % NXCD, xcd = wgid % NXCD, off = wgid / NXCD; wgid = (xcd < r ? xcd * (q + 1) : r * (q + 1) + (xcd - r) * q) + off; }
        const int nig = WGM * nN, gid = wgid / nig, fm = gid * WGM, gsz = (nM - fm) < WGM ? (nM - fm) : WGM;
        u.pm = fm + ((wgid % nig) % gsz); u.pn = (wgid % nig) / gsz; u.idx = i >> dup; return true;
    }
    __device__ __forceinline__ void a_ready(const Unit&) const {}
    __device__ __forceinline__ void done(const Unit&) const {}
};
__device__ __forceinline__ unsigned cvt_pk_bf16(float lo, float hi) { unsigned r; asm volatile("v_cvt_pk_bf16_f32 %0, %1, %2" : "=v"(r) : "v"(lo), "v"(hi)); return r; }
template <class Epi, class Sched, bool ALIGN_EPI = false, bool SP2 = false, int AUXA = 0, bool F8 = false>
__device__ __forceinline__ void gemm_phase(PG8_LAS unsigned char* lds, const Gemm g, const Sched& S, const Epi& E) {
    const int tid = threadIdx.x, wid = __builtin_amdgcn_readfirstlane(tid >> 6), lane = tid & 63, wr = wid >> 2, wc = wid & 3, fr = lane & 15, fq = lane >> 4;
    const int K = g.K, nt = K / BK;
    unsigned voffA[2], voffB[2];
#pragma unroll
    for (int i = 0; i < 2; ++i) { int R, C; stage_rc(tid * 16 + i * 8192, R, C); const int Rb = Epi::PERM ? ((R & ~31) + perm32(R & 31)) : R;
        voffA[i] = (unsigned)(R * K + C) * 2u; voffB[i] = (unsigned)(Rb * K + C) * 2u; }
    const size_t kstep = (size_t)(BK * 2);
    const size_t hstep = (size_t)HALF * K * 2;
    const size_t tstep = 2 * hstep;
    const unsigned ldsw = (unsigned)wid * 1024u;
    const int aoff = lds_byte(wr * 64 + fr, fq * 8), boff = lds_byte(wc * 32 + fr, fq * 8);
#define PG8_SA(b, h) (((b) * 2 + (h)) * HTB)
#define PG8_SB(b, h) ((4 + (b) * 2 + (h)) * HTB)
#define PG8_STAGE_X(bufoff, gbase, voff, aux) do { _Pragma("unroll") for (int _i = 0; _i < 2; ++_i) \
        __builtin_amdgcn_global_load_lds((const unsigned*)((const char*)(gbase) + (voff)[_i]), (PG8_LAS unsigned*)(lds + (bufoff) + ldsw + _i * 8192), 16, 0, aux); } while (0)
#define PG8_STAGE(bufoff, gbase, voff) do { if constexpr (AUXA != 0) { if ((bufoff) < 4 * HTB) PG8_STAGE_X(bufoff, gbase, voff, AUXA); else PG8_STAGE_X(bufoff, gbase, voff, 0); } else PG8_STAGE_X(bufoff, gbase, voff, 0); } while (0)
#define PG8_LDA(dst, b, h) do { _Pragma("unroll") for (int m = 0; m < 4; ++m) _Pragma("unroll") for (int k = 0; k < 2; ++k) dst[m].hf[k] = *(const PG8_LAS bf16x8*)(lds + PG8_SA(b, h) + aoff + m * 2048 + k * 1024); } while (0)
#define PG8_LDB(dst, b, h) do { _Pragma("unroll") for (int n = 0; n < 2; ++n) _Pragma("unroll") for (int k = 0; k < 2; ++k) dst[n].hf[k] = *(const PG8_LAS bf16x8*)(lds + PG8_SB(b, h) + boff + n * 2048 + k * 1024); } while (0)
#define PG8_MMA(ai, bj, At, Bt) do { __builtin_amdgcn_s_setprio(1); if constexpr (F8) { _Pragma("unroll") for (int m = 0; m < 4; ++m) _Pragma("unroll") for (int n = 0; n < 2; ++n) \
        asm volatile("v_mfma_scale_f32_16x16x128_f8f6f4 %0, %1, %2, %0, %3, %3 op_sel_hi:[0,0,0]" : "+v"(acc[ai][bj][m][n]) : "v"(Bt[n].w), "v"(At[m].w), "v"(sc127)); } else { \
        _Pragma("unroll") for (int m = 0; m < 4; ++m) _Pragma("unroll") for (int n = 0; n < 2; ++n) _Pragma("unroll") for (int k = 0; k < 2; ++k) \
        acc[ai][bj][m][n] = __builtin_amdgcn_mfma_f32_16x16x32_bf16(Bt[n].hf[k], At[m].hf[k], acc[ai][bj][m][n], 0, 0, 0); } __builtin_amdgcn_s_setprio(0); } while (0)
#define PG8_WAIT_V(n) asm volatile("s_waitcnt vmcnt(" #n ")" ::: "memory")
#define PG8_WAIT_L(n) asm volatile("s_waitcnt lgkmcnt(" #n ")" ::: "memory")
#define PG8_BAR __builtin_amdgcn_s_barrier()
#define PG8_SCHED __builtin_amdgcn_sched_barrier(0)
    Unit cur, nxt; int ui = 0;
    if (!S.next(0, cur)) return;
    f32x4 acc[2][2][4][2];
    if constexpr (Epi::INIT) { E.init(acc, cur, wr, wc, fr, fq); } else {
#pragma unroll
    for (int a = 0; a < 2; ++a)
#pragma unroll
        for (int b = 0; b < 2; ++b)
#pragma unroll
            for (int m = 0; m < 4; ++m)
#pragma unroll
                for (int n = 0; n < 2; ++n) acc[a][b][m][n] = (f32x4){0.f, 0.f, 0.f, 0.f};
    }
    union Frag { bf16x8 hf[2]; pg8::i32x8 w; };
    Frag At[4], B0[2], B1[2];
    const int sc127 = 127;
    const char* cA = (const char*)g.A + (size_t)cur.pm * tstep + (size_t)(cur.pm >> 3) * g.a_extra; const char* cB = (const char*)g.Bt + (size_t)cur.pn * tstep;
    S.a_ready(cur);
    if constexpr (SP2) {
        PG8_STAGE(PG8_SB(0, 0), cB, voffB); PG8_STAGE(PG8_SB(0, 1), cB + hstep, voffB); PG8_STAGE(PG8_SA(0, 0), cA, voffA); PG8_STAGE(PG8_SA(0, 1), cA + hstep, voffA);
        if (wr == 1) PG8_BAR;
        PG8_WAIT_V(2); PG8_BAR;
        PG8_STAGE(PG8_SB(1, 0), cB + kstep, voffB); PG8_STAGE(PG8_SA(1, 0), cA + kstep, voffA); PG8_STAGE(PG8_SB(1, 1), cB + hstep + kstep, voffB);
        PG8_WAIT_V(6); PG8_BAR;
    } else {
        PG8_STAGE(PG8_SB(0, 0), cB, voffB); PG8_STAGE(PG8_SA(0, 0), cA, voffA); PG8_STAGE(PG8_SB(0, 1), cB + hstep, voffB); PG8_STAGE(PG8_SA(0, 1), cA + hstep, voffA);
        if (wr == 1) PG8_BAR;
        PG8_WAIT_V(4); PG8_BAR;
        PG8_STAGE(PG8_SB(1, 0), cB + kstep, voffB); PG8_STAGE(PG8_SA(1, 0), cA + kstep, voffA); PG8_STAGE(PG8_SB(1, 1), cB + hstep + kstep, voffB);
        PG8_WAIT_V(6); PG8_BAR;
    }
    for (;;) {
        const bool has_next = S.next(ui + 1, nxt);
        const char* nA = has_next ? (const char*)g.A + (size_t)nxt.pm * tstep + (size_t)(nxt.pm >> 3) * g.a_extra : cA; const char* nB = has_next ? (const char*)g.Bt + (size_t)nxt.pn * tstep : cB;
        for (int t = 0; t < nt; t += 2) {
            const bool last = (t == nt - 2);
            const char* a1 = cA + (size_t)(t + 1) * kstep;
            const char* a2 = last ? nA : cA + (size_t)(t + 2) * kstep; const char* b2 = last ? nB : cB + (size_t)(t + 2) * kstep;
            const char* a3 = a2 + kstep; const char* b3 = b2 + kstep;
            if (last && has_next) S.a_ready(nxt);
            if constexpr (Epi::MIDK) { if (t == (nt >> 1)) E.mid(acc, cur, wr, wc, fr, fq); }
            if constexpr (SP2) {
            PG8_LDB(B0, 0, 0); PG8_LDB(B1, 0, 1); PG8_SCHED; PG8_LDA(At, 0, 0); PG8_STAGE(PG8_SA(1, 1), a1 + hstep, voffA);
            PG8_WAIT_V(8); PG8_WAIT_L(0); PG8_BAR; PG8_MMA(0, 0, At, B0); PG8_MMA(0, 1, At, B1); PG8_BAR; PG8_SCHED;
            PG8_LDA(At, 0, 1); PG8_STAGE(PG8_SB(0, 0), b2, voffB); PG8_STAGE(PG8_SB(0, 1), b2 + hstep, voffB); PG8_STAGE(PG8_SA(0, 0), a2, voffA);
            PG8_WAIT_V(8); PG8_WAIT_L(0); PG8_BAR; PG8_MMA(1, 0, At, B0); PG8_MMA(1, 1, At, B1); PG8_BAR; PG8_SCHED;
            PG8_LDB(B0, 1, 0); PG8_LDB(B1, 1, 1); PG8_SCHED; PG8_LDA(At, 1, 0); PG8_STAGE(PG8_SA(0, 1), a2 + hstep, voffA);
            PG8_WAIT_V(8); PG8_WAIT_L(0); PG8_BAR; PG8_MMA(0, 0, At, B0); PG8_MMA(0, 1, At, B1); PG8_BAR; PG8_SCHED;
            PG8_LDA(At, 1, 1); PG8_STAGE(PG8_SB(1, 0), b3, voffB); PG8_STAGE(PG8_SB(1, 1), b3 + hstep, voffB); PG8_STAGE(PG8_SA(1, 0), a3, voffA);
            PG8_WAIT_V(8); PG8_WAIT_L(0); PG8_BAR; PG8_MMA(1, 0, At, B0); PG8_MMA(1, 1, At, B1); PG8_BAR; PG8_SCHED;
            } else {
            PG8_LDB(B0, 0, 0); PG8_SCHED; PG8_LDA(At, 0, 0); PG8_STAGE(PG8_SA(1, 1), a1 + hstep, voffA);
            PG8_WAIT_L(8); PG8_BAR; PG8_WAIT_L(0); PG8_MMA(0, 0, At, B0); PG8_BAR; PG8_SCHED;
            PG8_LDB(B1, 0, 1); PG8_STAGE(PG8_SB(0, 0), b2, voffB);
            PG8_BAR; PG8_WAIT_L(0); PG8_MMA(0, 1, At, B1); PG8_BAR;
            PG8_LDA(At, 0, 1); PG8_STAGE(PG8_SA(0, 0), a2, voffA);
            PG8_BAR; PG8_WAIT_L(0); PG8_MMA(1, 0, At, B0); PG8_BAR; PG8_SCHED;
            PG8_STAGE(PG8_SB(0, 1), b2 + hstep, voffB);
            PG8_WAIT_V(6); PG8_BAR; PG8_MMA(1, 1, At, B1); PG8_BAR;
            PG8_LDB(B0, 1, 0); PG8_SCHED; PG8_LDA(At, 1, 0); PG8_STAGE(PG8_SA(0, 1), a2 + hstep, voffA);
            PG8_WAIT_L(8); PG8_BAR; PG8_WAIT_L(0); PG8_MMA(0, 0, At, B0); PG8_BAR; PG8_SCHED;
            PG8_LDB(B1, 1, 1); PG8_STAGE(PG8_SB(1, 0), b3, voffB);
            PG8_BAR; PG8_WAIT_L(0); PG8_MMA(0, 1, At, B1); PG8_BAR;
            PG8_LDA(At, 1, 1); PG8_STAGE(PG8_SA(1, 0), a3, voffA);
            PG8_BAR; PG8_WAIT_L(0); PG8_MMA(1, 0, At, B0); PG8_BAR; PG8_SCHED;
            PG8_STAGE(PG8_SB(1, 1), b3 + hstep, voffB);
            PG8_WAIT_V(6); PG8_BAR; PG8_MMA(1, 1, At, B1); PG8_BAR;
            }
        }
        if constexpr (F8) { asm volatile("s_nop 15\n\ts_nop 15\n\ts_nop 15" ::: "memory"); }
        if constexpr (ALIGN_EPI) { if (wr == 0) PG8_BAR; }
        if constexpr (!Epi::AFTER_DRAIN) { E(acc, cur, wr, wc, fr, fq); S.done(cur); }
        if (!has_next) break;
        if constexpr (Epi::INIT) { E.init(acc, nxt, wr, wc, fr, fq); } else {
#pragma unroll
        for (int a = 0; a < 2; ++a)
#pragma unroll
            for (int b = 0; b < 2; ++b)
#pragma unroll
                for (int m = 0; m < 4; ++m)
#pragma unroll
                    for (int n = 0; n < 2; ++n) acc[a][b][m][n] = (f32x4){0.f, 0.f, 0.f, 0.f};
        }
        cur = nxt; cA = nA; cB = nB; ++ui;
        if constexpr (ALIGN_EPI) { if (wr == 1) PG8_BAR; }
    }
    PG8_WAIT_V(0);
    if constexpr (!ALIGN_EPI) { if (wr == 0) PG8_BAR; }
    PG8_BAR;
    if constexpr (Epi::AFTER_DRAIN) { E.fused(acc, cur, wr, wc, fr, fq, lds, wid, lane); S.done(cur); }
#undef PG8_SA
#undef PG8_SB
#undef PG8_STAGE
#undef PG8_STAGE_X
#undef PG8_LDA
#undef PG8_LDB
#undef PG8_MMA
#undef PG8_WAIT_V
#undef PG8_WAIT_L
#undef PG8_BAR
#undef PG8_SCHED
}
}
#define LAS __attribute__((address_space(3)))
typedef unsigned short bf16;
typedef short bf16x8 __attribute__((ext_vector_type(8)));
typedef short s16x4 __attribute__((ext_vector_type(4)));
typedef float f32x4 __attribute__((ext_vector_type(4)));
typedef float f32x2 __attribute__((ext_vector_type(2)));
typedef unsigned u32x4 __attribute__((ext_vector_type(4)));
typedef unsigned u32x2 __attribute__((ext_vector_type(2)));
typedef __bf16 bf16x2v __attribute__((ext_vector_type(2)));
__device__ __forceinline__ unsigned cvt_pk_bf16(float lo, float hi) { const f32x2 v = {lo, hi}; return __builtin_bit_cast(unsigned, __builtin_convertvector(v, bf16x2v)); }

constexpr int T = 16384, SEQ = 2048, D = 2048, DIN = 10240, DFF = 8192;
constexpr float EPS = 1e-6f;
constexpr size_t MiB = 1u << 20;
constexpr size_t WS_ROPE = 1 * MiB;
constexpr size_t WS_SSQ = 2 * MiB;
constexpr size_t WS_LSE = 10 * MiB;
constexpr size_t WS_HP = 11 * MiB;
constexpr size_t WS_SMALL = 13 * MiB;
constexpr size_t WS_WIN = 14 * MiB;
constexpr size_t WS_WP = 54 * MiB;
constexpr size_t WS_WOUT = 58 * MiB;
constexpr size_t WS_WUP = 66 * MiB;
constexpr size_t WS_WDN = 98 * MiB;
constexpr size_t WS_Q = 130 * MiB, WS_K = 138 * MiB, WS_V = 146 * MiB, WS_G = 154 * MiB, WS_U = 138 * MiB, WS_END = 450 * MiB;
constexpr int WOUT_SH = 6, MIX_SH = 4;
constexpr size_t X_MIX8 = 40 * MiB - (size_t)SEQ * 2048;
constexpr int WP_SH = 5, OAB_SH = 4;
constexpr size_t X_OAB8 = 16 * MiB - (size_t)SEQ * 1024;
constexpr size_t X_G8 = 40 * MiB - (size_t)SEQ * 4096;
constexpr int WG_SH = 6;
constexpr size_t WS_WG8 = WS_WIN + 24 * MiB;
constexpr size_t OUT_XN8 = 12 * MiB, X_XN8 = 16 * MiB - (size_t)SEQ * 2048;
constexpr size_t ARENA_EL = 40 * MiB / 2;
constexpr size_t X_QKV = ARENA_EL - (size_t)SEQ * 2048, X_G = ARENA_EL - (size_t)SEQ * 4096, X_U = ARENA_EL - (size_t)SEQ * 8192;
constexpr size_t OUT_OAB = 8 * MiB, OUTB_EL = 16 * MiB / 2;
constexpr size_t X_XN = OUTB_EL - (size_t)SEQ * 2048, X_OG = OUTB_EL - (size_t)SEQ * 1536, X_OAB = OUTB_EL - (size_t)SEQ * 1024;
constexpr int KP = 272;
constexpr int LDS_KV = 0, LDS_SK = 139264, LDS_RPB = 141312, LDS_BYTES = 147456;

__device__ __forceinline__ float bf_lo(unsigned u) { return __uint_as_float(u << 16); }
__device__ __forceinline__ float bf_hi(unsigned u) { return __uint_as_float(u & 0xffff0000u); }
__device__ __forceinline__ float wave_sum(float v) {
#pragma unroll
    for (int o = 1; o < 64; o <<= 1) v += __shfl_xor(v, o);
    return v;
}

struct Args { const float* in[15]; float* out; unsigned char* ws; int ph_lo, ph_hi; };

constexpr int TP = 136;
template <bool PERMQK, int F8 = -1>
__device__ __forceinline__ void p0_item64(const float* __restrict__ W, int N, bf16* __restrict__ WT, int ldt, int col_off, const float* __restrict__ g, LAS unsigned char* til, int item, int lane) {
    const int nblk = N / 64, kb = item / nblk, nb = item % nblk, k0 = 64 * kb, n0 = 64 * nb;
    const int l16 = lane & 15, lr = lane >> 4, sc = 4 * l16;
    const bool perm = PERMQK && n0 < 4096;
    int srccol = n0 + sc;
    if (perm) { const int hb = n0 & ~127, hp = (n0 >> 6) & 1; srccol = hb + (sc < 32 ? 32 * hp + sc : 64 + 32 * hp + (sc - 32)); }
    f32x4 v[16];
#pragma unroll
    for (int it = 0; it < 16; ++it) v[it] = __builtin_nontemporal_load((const f32x4*)(W + (size_t)(k0 + 4 * it + lr) * N + srccol));
#pragma unroll
    for (int it = 0; it < 16; ++it) { const int kk = 4 * it + lr; const float gs = (g ? g[k0 + kk] : 1.0f) * (float)(1 << (F8 >= 0 ? F8 : 0));
        u32x2 o; o.x = cvt_pk_bf16(v[it][0] * gs, v[it][1] * gs); o.y = cvt_pk_bf16(v[it][2] * gs, v[it][3] * gs);
        *(LAS u32x2*)(til + kk * TP + sc * 2) = o; }
    const int i = lane & 15, gq = lane >> 4, q = i >> 2, p = i & 3;
#pragma unroll
    for (int nbk = 0; nbk < 4; ++nbk) {
        const int colp = perm ? (8 * nbk + 4 * (p & 1) + 32 * (p >> 1)) : (16 * nbk + 4 * p);
        const int drow = perm ? (n0 + 2 * (8 * nbk + (i & 7)) + (i >> 3)) : (n0 + 16 * nbk + i);
#pragma unroll
        for (int k2 = 0; k2 < 2; ++k2) {
            LAS unsigned char* a0 = til + (32 * k2 + 8 * gq + q) * TP + colp * 2;
            const s16x4 lo = __builtin_amdgcn_ds_read_tr16_b64_v4i16((LAS s16x4*)a0), hi = __builtin_amdgcn_ds_read_tr16_b64_v4i16((LAS s16x4*)(a0 + 4 * TP));
            const bf16x8 ov = __builtin_shufflevector(lo, hi, 0, 1, 2, 3, 4, 5, 6, 7);
            if constexpr (F8 >= 0) { const u32x4 w = __builtin_bit_cast(u32x4, ov); u32x2 o8;
                int t0 = __builtin_amdgcn_cvt_pk_fp8_f32(bf_lo(w.x), bf_hi(w.x), 0, false); t0 = __builtin_amdgcn_cvt_pk_fp8_f32(bf_lo(w.y), bf_hi(w.y), t0, true);
                int t1 = __builtin_amdgcn_cvt_pk_fp8_f32(bf_lo(w.z), bf_hi(w.z), 0, false); t1 = __builtin_amdgcn_cvt_pk_fp8_f32(bf_lo(w.w), bf_hi(w.w), t1, true);
                o8.x = (unsigned)t0; o8.y = (unsigned)t1;
                *(u32x2*)((unsigned char*)WT + (size_t)drow * ldt + col_off + k0 + 32 * k2 + 8 * gq) = o8; }
            else *(bf16x8*)(WT + (size_t)drow * ldt + col_off + k0 + 32 * k2 + 8 * gq) = ov;
        }
    }
}

__device__ __forceinline__ void p0_prologue(const Args& a, LAS unsigned char* lds) {
    const int tid = threadIdx.x, lane = tid & 63, wave = __builtin_amdgcn_readfirstlane(tid >> 6);
    LAS unsigned char* til = lds + wave * (64 * TP);
    const int gw = blockIdx.x * 8 + wave, NGW = gridDim.x * 8;
    unsigned char* ws = a.ws;
    constexpr int I_IN = (D / 64) * (DIN / 64), I_P = (512 / 64) * (D / 64), I_O = (D / 64) * (D / 64), I_UP = (D / 64) * (DFF / 64), I_DN = (DFF / 64) * (D / 64);
    constexpr int NITEMS = I_IN + 2 * I_P + I_O + I_UP + I_DN;
    for (int it = gw; it < NITEMS; it += NGW) {
        int r = it;
        if (r < I_IN) { p0_item64<true, WG_SH>(a.in[2], DIN, (bf16*)(ws + WS_WIN), D, 0, a.in[1], til, r, lane); continue; } r -= I_IN;
        if (r < I_P) { p0_item64<false, WP_SH>(a.in[9], D, (bf16*)(ws + WS_WP), 1024, 0, nullptr, til, r, lane); continue; } r -= I_P;
        if (r < I_P) { p0_item64<false, WP_SH>(a.in[10], D, (bf16*)(ws + WS_WP), 1024, 512, nullptr, til, r, lane); continue; } r -= I_P;
        if (r < I_O) { p0_item64<false, WOUT_SH>(a.in[11], D, (bf16*)(ws + WS_WOUT), D, 0, nullptr, til, r, lane); continue; } r -= I_O;
        if (r < I_UP) { p0_item64<false>(a.in[13], DFF, (bf16*)(ws + WS_WUP), D, 0, a.in[12], til, r, lane); continue; } r -= I_UP;
        p0_item64<false>(a.in[14], D, (bf16*)(ws + WS_WDN), DFF, 0, nullptr, til, r, lane);
    }
    { f32x2* rt = (f32x2*)(ws + WS_ROPE);
      for (int e = blockIdx.x * 512 + tid; e < SEQ * 64; e += gridDim.x * 512) { const int pos = e >> 6, i = e & 63;
          const float inv = powf(10000.0f, -(float)(2 * i) / 128.0f); const float ang = (float)pos * inv; rt[e] = (f32x2){cosf(ang), sinf(ang)}; } }
    { float* sm = (float*)(ws + WS_SMALL); const int e = blockIdx.x * 512 + tid;
      if (e < 512) sm[e] = a.in[4 + (e >> 7)][e & 127]; else if (e < 512 + 4096) sm[e] = a.in[3][e - 512]; }
    for (int m = (blockIdx.x & 7) * SEQ + (blockIdx.x >> 3) * (SEQ / (NGW / 64)) + wave * (SEQ / (NGW / 8)), mend = m + SEQ / (NGW / 8); m < mend; m += 2) {
        const f32x4* xr = (const f32x4*)(a.in[0] + (size_t)m * D) + lane; f32x4 v[16]; float s0 = 0.f, s1 = 0.f;
#pragma unroll
        for (int j = 0; j < 16; ++j) v[j] = __builtin_nontemporal_load(xr + 64 * j);
#pragma unroll
        for (int j = 0; j < 8; ++j) { s0 += (v[j].x * v[j].x + v[j].y * v[j].y) + (v[j].z * v[j].z + v[j].w * v[j].w);
            s1 += (v[8 + j].x * v[8 + j].x + v[8 + j].y * v[8 + j].y) + (v[8 + j].z * v[8 + j].z + v[8 + j].w * v[8 + j].w); }
#pragma unroll
        for (int o = 1; o < 64; o <<= 1) { s0 += __shfl_xor(s0, o); s1 += __shfl_xor(s1, o); }
        const float r0 = rsqrtf(s0 * (1.0f / D) + EPS), r1 = rsqrtf(s1 * (1.0f / D) + EPS);
        unsigned* o4 = (unsigned*)((unsigned char*)a.out + OUT_XN8 + (size_t)m * 2048 + (size_t)(m >> 11) * X_XN8) + lane;
#pragma unroll
        for (int j = 0; j < 16; ++j) { const float rs = j < 8 ? r0 : r1; int t = __builtin_amdgcn_cvt_pk_fp8_f32(v[j].x * rs, v[j].y * rs, 0, false); t = __builtin_amdgcn_cvt_pk_fp8_f32(v[j].z * rs, v[j].w * rs, t, true); o4[64 * j] = (unsigned)t; }
    }
}
typedef f32x4 AccT[2][2][4][2];

struct EpiProj {
    static constexpr bool PERM = true, AFTER_DRAIN = false, MIDK = false, INIT = false;
    unsigned char* ws;
    __device__ __forceinline__ void operator()(const AccT& acc, const pg8::Unit& u, int wr, int wc, int fr, int fq) const {
        const int row0 = u.pm * 256 + wr * 64 + fr, cl = wc * 32 + 8 * fq;
        constexpr float PSC = 1.0f / (float)(1 << WG_SH);
        const size_t bb = (size_t)(u.pm >> 3);
        bf16* const V = (bf16*)(ws + WS_V) + bb * X_QKV; bf16* const G = (bf16*)(ws + WS_G) + bb * X_G; float* const ssq = (float*)(ws + WS_SSQ); const f32x4* const rope = (const f32x4*)(ws + WS_ROPE);
        const float* const small = (const float*)(ws + WS_SMALL); const float* const bgate = small + 512;
        if (u.pn < 16) {
            const bool isk = u.pn >= 8; bf16* O = (bf16*)(ws + (isk ? WS_K : WS_Q)) + bb * X_QKV;
            const int i0 = 16 * wc + 4 * fq;
            const bool dorope = (u.pn & 7) < 6;
            const float* gn = small + (dorope ? 0 : 256) + (isk ? 128 : 0);
            const f32x4 g1 = *(const f32x4*)(gn + i0), g2 = *(const f32x4*)(gn + 64 + i0);
#pragma unroll
            for (int ai = 0; ai < 2; ++ai) {
                f32x4 c01[4], c23[4];
#pragma unroll
                for (int m = 0; m < 4; ++m) { c01[m] = (f32x4){1.f, 0.f, 1.f, 0.f}; c23[m] = c01[m];
                    if (dorope) { const f32x4* rp = rope + ((size_t)((row0 + ai * 128 + m * 16) & (SEQ - 1)) * 64 + i0) / 2; c01[m] = rp[0]; c23[m] = rp[1]; } }
#pragma unroll
                for (int m = 0; m < 4; ++m)
#pragma unroll
                    for (int bj = 0; bj < 2; ++bj) {
                        const int head = (u.pn & 7) * 2 + bj, row = row0 + ai * 128 + m * 16;
                        const f32x4 v0 = acc[ai][bj][m][0] * PSC, v1 = acc[ai][bj][m][1] * PSC;
                        float ss = (v0[0] * v0[0] + v0[1] * v0[1]) + (v0[2] * v0[2] + v0[3] * v0[3]) + (v1[0] * v1[0] + v1[1] * v1[1]) + (v1[2] * v1[2] + v1[3] * v1[3]);
                        ss += __shfl_xor(ss, 16); ss += __shfl_xor(ss, 32);
                        if (fq == 0) ssq[((size_t)((isk ? 16 : 0) + head) * T + row) * 4 + wc] = ss;
                        float a0 = v0[0] * g1[0], b0 = v0[1] * g2[0], a1 = v0[2] * g1[1], b1 = v0[3] * g2[1];
                        float a2 = v1[0] * g1[2], b2 = v1[1] * g2[2], a3 = v1[2] * g1[3], b3 = v1[3] * g2[3];
                        { float t;
                            t = a0 * c01[m][0] - b0 * c01[m][1]; b0 = b0 * c01[m][0] + a0 * c01[m][1]; a0 = t;
                            t = a1 * c01[m][2] - b1 * c01[m][3]; b1 = b1 * c01[m][2] + a1 * c01[m][3]; a1 = t;
                            t = a2 * c23[m][0] - b2 * c23[m][1]; b2 = b2 * c23[m][0] + a2 * c23[m][1]; a2 = t;
                            t = a3 * c23[m][2] - b3 * c23[m][3]; b3 = b3 * c23[m][2] + a3 * c23[m][3]; a3 = t; }
                        u32x4 w; w.x = cvt_pk_bf16(a0, b0); w.y = cvt_pk_bf16(a1, b1); w.z = cvt_pk_bf16(a2, b2); w.w = cvt_pk_bf16(a3, b3);
                        *(u32x4*)(O + (size_t)row * D + head * 128 + cl) = w;
                    }
            }
        } else if (u.pn < 24) {
#pragma unroll
            for (int ai = 0; ai < 2; ++ai)
#pragma unroll
                for (int m = 0; m < 4; ++m) { bf16* rowp = V + (size_t)(row0 + ai * 128 + m * 16) * D + (u.pn - 16) * 256 + cl;
#pragma unroll
                    for (int bj = 0; bj < 2; ++bj) { const f32x4 v0 = acc[ai][bj][m][0] * PSC, v1 = acc[ai][bj][m][1] * PSC;
                        u32x4 w; w.x = cvt_pk_bf16(v0[0], v0[1]); w.y = cvt_pk_bf16(v0[2], v0[3]); w.z = cvt_pk_bf16(v1[0], v1[1]); w.w = cvt_pk_bf16(v1[2], v1[3]);
                        *(u32x4*)(rowp + bj * 128) = w; } }
        } else {
            const int gc0 = (u.pn - 24) * 256 + cl;
            unsigned char* const G8 = (unsigned char*)(ws + WS_G) + bb * X_G8;
            f32x4 bv[2][2];
#pragma unroll
            for (int bj = 0; bj < 2; ++bj)
#pragma unroll
                for (int n = 0; n < 2; ++n) bv[bj][n] = *(const f32x4*)(bgate + gc0 + bj * 128 + 4 * n) * (-1.4426950408889634f) - 7.994353436858858f;
#pragma unroll
            for (int ai = 0; ai < 2; ++ai)
#pragma unroll
                for (int m = 0; m < 4; ++m) { unsigned char* rowp = G8 + (size_t)(row0 + ai * 128 + m * 16) * 4096 + gc0;
#pragma unroll
                    for (int bj = 0; bj < 2; ++bj) { f32x4 v0 = acc[ai][bj][m][0] * (-1.4426950408889634f * PSC) + bv[bj][0], v1 = acc[ai][bj][m][1] * (-1.4426950408889634f * PSC) + bv[bj][1];
#pragma unroll
                        for (int j = 0; j < 4; ++j) { v0[j] = __builtin_amdgcn_rcpf(__builtin_amdgcn_exp2f(v0[j]) + (1.0f / 255.0f)); v1[j] = __builtin_amdgcn_rcpf(__builtin_amdgcn_exp2f(v1[j]) + (1.0f / 255.0f)); }
                        u32x2 w8; w8.x = 0u; w8.y = 0u;
                        w8.x = __builtin_amdgcn_cvt_pk_u8_f32(v0[0], 0, w8.x); w8.x = __builtin_amdgcn_cvt_pk_u8_f32(v0[1], 1, w8.x); w8.x = __builtin_amdgcn_cvt_pk_u8_f32(v0[2], 2, w8.x); w8.x = __builtin_amdgcn_cvt_pk_u8_f32(v0[3], 3, w8.x);
                        w8.y = __builtin_amdgcn_cvt_pk_u8_f32(v1[0], 0, w8.y); w8.y = __builtin_amdgcn_cvt_pk_u8_f32(v1[1], 1, w8.y); w8.y = __builtin_amdgcn_cvt_pk_u8_f32(v1[2], 2, w8.y); w8.y = __builtin_amdgcn_cvt_pk_u8_f32(v1[3], 3, w8.y);
                        __builtin_nontemporal_store(w8, (u32x2*)(rowp + bj * 128)); } }
        }
    }
};

struct EpiGate {
    static constexpr bool PERM = true, AFTER_DRAIN = false, MIDK = false, INIT = false;
    unsigned char* ws;
    __device__ __forceinline__ void operator()(const AccT& acc, const pg8::Unit& u, int wr, int wc, int fr, int fq) const {
        const int row0 = u.pm * 256 + wr * 64 + fr, gc0 = u.pn * 256 + wc * 32 + 8 * fq;
        bf16* const G = (bf16*)(ws + WS_G) + (size_t)(u.pm >> 3) * X_G; const float* const bgate = (const float*)(ws + WS_SMALL) + 512;
        constexpr float SC = 1.0f / (float)(1 << WG_SH);
        f32x4 bv[2][2];
#pragma unroll
        for (int bj = 0; bj < 2; ++bj)
#pragma unroll
            for (int n = 0; n < 2; ++n) bv[bj][n] = *(const f32x4*)(bgate + gc0 + bj * 128 + 4 * n);
#pragma unroll
        for (int ai = 0; ai < 2; ++ai)
#pragma unroll
            for (int m = 0; m < 4; ++m) { bf16* rowp = G + (size_t)(row0 + ai * 128 + m * 16) * 4096 + gc0;
#pragma unroll
                for (int bj = 0; bj < 2; ++bj) { f32x4 v0 = acc[ai][bj][m][0] * SC + bv[bj][0], v1 = acc[ai][bj][m][1] * SC + bv[bj][1];
#pragma unroll
                    for (int j = 0; j < 4; ++j) { v0[j] = __builtin_amdgcn_rcpf(1.0f + __expf(-v0[j])); v1[j] = __builtin_amdgcn_rcpf(1.0f + __expf(-v1[j])); }
                    u32x4 w; w.x = cvt_pk_bf16(v0[0], v0[1]); w.y = cvt_pk_bf16(v0[2], v0[3]); w.z = cvt_pk_bf16(v1[0], v1[1]); w.w = cvt_pk_bf16(v1[2], v1[3]);
                    __builtin_nontemporal_store(w, (u32x4*)(rowp + bj * 128)); } }
    }
};

__device__ __forceinline__ float ub(unsigned w, int i) { return (float)((w >> (8 * i)) & 0xffu); }
struct EpiMix {
    static constexpr bool PERM = true, AFTER_DRAIN = false, MIDK = true, INIT = false;
    const unsigned char* G; bf16* O;
    __device__ __forceinline__ void mid(AccT& acc, const pg8::Unit& u, int wr, int wc, int fr, int fq) const {
        const int row0 = u.pm * 256 + wr * 64 + fr, col0 = u.pn * 256 + wc * 32 + 8 * fq;
#pragma unroll
        for (int ai = 0; ai < 2; ++ai) {
            u32x2 ga[4][2], gb[4][2];
#pragma unroll
            for (int m = 0; m < 4; ++m) { unsigned goff = (unsigned)(row0 + ai * 128 + m * 16) * 4096u + (unsigned)col0; asm volatile("" : "+v"(goff)); const unsigned char* gp = G + (size_t)(u.pm >> 3) * X_G8 + goff;
#pragma unroll
                for (int bj = 0; bj < 2; ++bj) { ga[m][bj] = *(const u32x2*)(gp + bj * 128); gb[m][bj] = *(const u32x2*)(gp + 2048 + bj * 128); } }
#pragma unroll
            for (int m = 0; m < 4; ++m)
#pragma unroll
                for (int bj = 0; bj < 2; ++bj) { const u32x2 a = ga[m][bj], b = gb[m][bj]; f32x4& v0 = acc[ai][bj][m][0]; f32x4& v1 = acc[ai][bj][m][1];
#pragma unroll
                    for (int i = 0; i < 4; ++i) { v0[i] *= ub(a.x, i) * __builtin_amdgcn_rcpf(fmaxf(ub(b.x, i), 1.0f)); v1[i] *= ub(a.y, i) * __builtin_amdgcn_rcpf(fmaxf(ub(b.y, i), 1.0f)); } }
            asm volatile("" ::: "memory");
        }
    }
    __device__ __forceinline__ void operator()(const AccT& acc, const pg8::Unit& u, int wr, int wc, int fr, int fq) const {
        const int row0 = u.pm * 256 + wr * 64 + fr, col0 = u.pn * 256 + wc * 32 + 8 * fq;
#pragma unroll
        for (int ai = 0; ai < 2; ++ai) {
            u32x2 gb[4][2];
#pragma unroll
            for (int m = 0; m < 4; ++m)
#pragma unroll
                for (int bj = 0; bj < 2; ++bj) gb[m][bj] = *(const u32x2*)(G + (size_t)(u.pm >> 3) * X_G8 + (size_t)(row0 + ai * 128 + m * 16) * 4096 + 2048 + col0 + bj * 128);
#pragma unroll
            for (int m = 0; m < 4; ++m) { const size_t r = (size_t)(row0 + ai * 128 + m * 16);
#pragma unroll
                for (int bj = 0; bj < 2; ++bj) { const u32x2 b = gb[m][bj]; const f32x4 v0 = acc[ai][bj][m][0], v1 = acc[ai][bj][m][1];
                    constexpr float MS = (float)(1 << MIX_SH) / ((float)(1 << (WP_SH + OAB_SH)) * 255.0f);
                    float g[8];
#pragma unroll
                    for (int i = 0; i < 4; ++i) { g[i] = fmaxf(ub(b.x, i), 1.0f) * MS; g[4 + i] = fmaxf(ub(b.y, i), 1.0f) * MS; }
                    int t0 = __builtin_amdgcn_cvt_pk_fp8_f32(v0[0] * g[0], v0[1] * g[1], 0, false); t0 = __builtin_amdgcn_cvt_pk_fp8_f32(v0[2] * g[2], v0[3] * g[3], t0, true);
                    int t1 = __builtin_amdgcn_cvt_pk_fp8_f32(v1[0] * g[4], v1[1] * g[5], 0, false); t1 = __builtin_amdgcn_cvt_pk_fp8_f32(v1[2] * g[6], v1[3] * g[7], t1, true);
                    u32x2 w8; w8.x = (unsigned)t0; w8.y = (unsigned)t1;
                    *(u32x2*)((unsigned char*)O + (size_t)(u.pm >> 3) * X_MIX8 + r * 2048 + col0 + bj * 128) = w8; } }
            asm volatile("" ::: "memory");
        }
    }
};

struct EpiRes1 {
    static constexpr bool PERM = false, AFTER_DRAIN = false, MIDK = false, INIT = true;
    const float* X; float* out; bf16* hb; float* hp;
    __device__ __forceinline__ void init(AccT& acc, const pg8::Unit& u, int wr, int wc, int fr, int fq) const {
        const int row0 = u.pm * 256 + wr * 64 + fr, col0 = u.pn * 256 + wc * 32 + 4 * fq;
#pragma unroll
        for (int ai = 0; ai < 2; ++ai)
#pragma unroll
            for (int m = 0; m < 4; ++m)
#pragma unroll
                for (int bj = 0; bj < 2; ++bj)
#pragma unroll
                    for (int n = 0; n < 2; ++n) acc[ai][bj][m][n] = __builtin_nontemporal_load((const f32x4*)(X + (size_t)(row0 + ai * 128 + m * 16) * D + col0 + bj * 128 + n * 16)) * (float)(1 << (WOUT_SH + MIX_SH));
    }
    __device__ __forceinline__ void operator()(const AccT& acc, const pg8::Unit& u, int wr, int wc, int fr, int fq) const {
        const int row0 = u.pm * 256 + wr * 64 + fr, col0 = u.pn * 256 + wc * 32 + 4 * fq;
#pragma unroll
        for (int ai = 0; ai < 2; ++ai)
#pragma unroll
            for (int m = 0; m < 4; ++m) { const size_t r = (size_t)(row0 + ai * 128 + m * 16); float ss = 0.f;
#pragma unroll
                for (int bj = 0; bj < 2; ++bj)
#pragma unroll
                    for (int n = 0; n < 2; ++n) { const size_t off = r * D + col0 + bj * 128 + n * 16;
                        const f32x4 h = acc[ai][bj][m][n] * (1.0f / (float)(1 << (WOUT_SH + MIX_SH)));
                        ss += (h[0] * h[0] + h[1] * h[1]) + (h[2] * h[2] + h[3] * h[3]);
                        u32x2 w; w.x = cvt_pk_bf16(h[0], h[1]); w.y = cvt_pk_bf16(h[2], h[3]); *(u32x2*)(hb + (size_t)(u.pm >> 3) * X_QKV + off) = w; }
                ss += __shfl_xor(ss, 16); ss += __shfl_xor(ss, 32);
                if (fq == 0) hp[r * 32 + u.pn * 4 + wc] = ss; }
    }
};

struct EpiUp {
    static constexpr bool PERM = true, AFTER_DRAIN = false, MIDK = false, INIT = false;
    const LAS float* rs; bf16* U;
    __device__ __forceinline__ void operator()(const AccT& acc, const pg8::Unit& u, int wr, int wc, int fr, int fq) const {
        const int lr0 = wr * 64 + fr, col0 = u.pn * 256 + wc * 32 + 8 * fq;
#pragma unroll
        for (int ai = 0; ai < 2; ++ai)
#pragma unroll
            for (int m = 0; m < 4; ++m) { const int lr = lr0 + ai * 128 + m * 16; const size_t r = (size_t)(u.pm * 256 + lr);
                const float s = rs[u.idx * 256 + lr];
#pragma unroll
                for (int bj = 0; bj < 2; ++bj) { f32x4 v0 = acc[ai][bj][m][0] * s, v1 = acc[ai][bj][m][1] * s;
#pragma unroll
                    for (int j = 0; j < 4; ++j) { const float a = fmaxf(v0[j], 0.f), b = fmaxf(v1[j], 0.f); v0[j] = a * a; v1[j] = b * b; }
                    u32x4 w; w.x = cvt_pk_bf16(v0[0], v0[1]); w.y = cvt_pk_bf16(v0[2], v0[3]); w.z = cvt_pk_bf16(v1[0], v1[1]); w.w = cvt_pk_bf16(v1[2], v1[3]);
                    __builtin_nontemporal_store(w, (u32x4*)(U + (size_t)(u.pm >> 3) * X_U + r * DFF + col0 + bj * 128)); } }
    }
};

struct EpiRes2 {
    static constexpr bool PERM = false, AFTER_DRAIN = false, MIDK = false, INIT = true;
    float* out; const bf16* hb;
    __device__ __forceinline__ void init(AccT& acc, const pg8::Unit& u, int wr, int wc, int fr, int fq) const {
        const int row0 = u.pm * 256 + wr * 64 + fr, col0 = u.pn * 256 + wc * 32 + 4 * fq;
        const bf16* hbb = hb + (size_t)(u.pm >> 3) * X_QKV;
#pragma unroll
        for (int ai = 0; ai < 2; ++ai)
#pragma unroll
            for (int m = 0; m < 4; ++m)
#pragma unroll
                for (int bj = 0; bj < 2; ++bj)
#pragma unroll
                    for (int n = 0; n < 2; ++n) { const u32x2 w = *(const u32x2*)(hbb + (size_t)(row0 + ai * 128 + m * 16) * D + col0 + bj * 128 + n * 16);
                        acc[ai][bj][m][n] = (f32x4){bf_lo(w.x), bf_hi(w.x), bf_lo(w.y), bf_hi(w.y)}; }
    }
    __device__ __forceinline__ void operator()(const AccT& acc, const pg8::Unit& u, int wr, int wc, int fr, int fq) const {
        const int row0 = u.pm * 256 + wr * 64 + fr, col0 = u.pn * 256 + wc * 32 + 4 * fq;
#pragma unroll
        for (int ai = 0; ai < 2; ++ai)
#pragma unroll
            for (int m = 0; m < 4; ++m) { const size_t r = (size_t)(row0 + ai * 128 + m * 16);
#pragma unroll
                for (int bj = 0; bj < 2; ++bj)
#pragma unroll
                    for (int n = 0; n < 2; ++n) __builtin_nontemporal_store(acc[ai][bj][m][n], (f32x4*)(out + r * D + col0 + bj * 128 + n * 16)); }
    }
};
#define MFMA16(a, b, c) __builtin_amdgcn_mfma_f32_16x16x32_bf16((a), (b), (c), 0, 0, 0)
__device__ __forceinline__ bf16x8 tr_pair(LAS unsigned char* p0, LAS unsigned char* p1) {
    const s16x4 lo = __builtin_amdgcn_ds_read_tr16_b64_v4i16((LAS s16x4*)p0), hi = __builtin_amdgcn_ds_read_tr16_b64_v4i16((LAS s16x4*)p1);
    return __builtin_shufflevector(lo, hi, 0, 1, 2, 3, 4, 5, 6, 7);
}
__device__ __forceinline__ bf16x8 pack_p(const f32x4& a, const f32x4& b) {
    u32x4 w; w.x = cvt_pk_bf16(a[0], a[1]); w.y = cvt_pk_bf16(a[2], a[3]); w.z = cvt_pk_bf16(b[0], b[1]); w.w = cvt_pk_bf16(b[2], b[3]);
    return __builtin_bit_cast(bf16x8, w);
}
struct QPre { bf16x8 q[4]; f32x4 sq, sk; };
struct AttnPtrs { const bf16 *Q, *K, *V; const float* ssq; bf16* og; float* lse; bf16* oab; const float* rpb; };


__device__ __forceinline__ void attn_issue_loads(const AttnPtrs& P, int unit, u32x4 (&pf)[16], QPre& qp, int tid) {
    const int lane_ = tid & 63, w_ = tid >> 6, j_ = lane_ & 15, g4_ = lane_ >> 4;
    if (unit < 1536) {
        const int bh = unit >> 4, idx = unit & 15, b = bh / 12, h = bh % 12, sh = 2 * (h >> 2), M = SEQ >> sh, lg = 4 - sh;
        const int qb = idx & ((1 << lg) - 1), r = idx >> lg, kstart = 128 * qb - 64;
#pragma unroll
        for (int p = 0; p < 8; ++p) { const int row = p * 32 + (tid >> 4), ch = tid & 15, m = kstart + row;
            pf[p] = (u32x4){0u, 0u, 0u, 0u}; pf[8 + p] = pf[p];
            if (m >= 0 && m < M) { const size_t off = (size_t)b * X_QKV + ((size_t)b * SEQ + ((size_t)m << sh) + r) * D + h * 128 + ch * 8; pf[p] = *(const u32x4*)(P.K + off); pf[8 + p] = *(const u32x4*)(P.V + off); } }
        { const size_t tokq = (size_t)b * SEQ + ((size_t)(128 * qb + 16 * w_ + j_) << sh) + r;
#pragma unroll
          for (int s = 0; s < 4; ++s) qp.q[s] = *(const bf16x8*)(P.Q + (size_t)b * X_QKV + tokq * D + h * 128 + 32 * s + 8 * g4_);
          qp.sq = *(const f32x4*)(P.ssq + ((size_t)h * T + tokq) * 4);
          const int mk = kstart + (tid & 255); qp.sk = (f32x4){0.f, 0.f, 0.f, 0.f};
          if (mk >= 0 && mk < M) qp.sk = *(const f32x4*)(P.ssq + ((size_t)(16 + h) * T + (size_t)b * SEQ + ((size_t)mk << sh) + r) * 4); }
    } else {
        const int ub = unit - 1536, b = ub >> 7, hB = (ub >> 5) & 3, r = ub & 31, rs = min(max(r - 4, 0), 24);
        const size_t tok0 = (size_t)b * SEQ + rs * 64;
#pragma unroll
        for (int p = 0; p < 16; ++p) { const int row = p * 32 + (tid >> 4), ch = tid & 15; pf[p] = *(const u32x4*)(P.K + (size_t)b * X_QKV + (tok0 + row) * D + (12 + hB) * 128 + ch * 8); }
    }
}

__device__ __forceinline__ void attnB_issue_k(const AttnPtrs& P, int ub, u32x4 (&pf)[16], int tid) {
    const int b = ub >> 7, hB = (ub >> 5) & 3, r = ub & 31, rs = min(max(r - 4, 0), 24);
    const size_t tok0 = (size_t)b * SEQ + rs * 64;
#pragma unroll
    for (int p = 0; p < 16; ++p) { const int row = p * 32 + (tid >> 4), ch = tid & 15; pf[p] = *(const u32x4*)(P.K + (size_t)b * X_QKV + (tok0 + row) * D + (12 + hB) * 128 + ch * 8); }
}

__device__ __forceinline__ void attnA_unit(const AttnPtrs& P, LAS unsigned char* lds, int unit, int next_unit, u32x4 (&pf)[16], QPre& qp) {
    const int tid = threadIdx.x, lane = tid & 63, w = __builtin_amdgcn_readfirstlane(tid >> 6), j = lane & 15, g4 = lane >> 4;
    const int bh = unit >> 4, idx = unit & 15, b = bh / 12, h = bh % 12, grp = h >> 2, sh = 2 * grp, M = SEQ >> sh, lg = 4 - sh;
    const int qb = idx & ((1 << lg) - 1), r = idx >> lg, kstart = 128 * qb - 64;
    LAS unsigned char* ldsK = lds + LDS_KV; LAS unsigned char* ldsV = lds + LDS_KV + 256 * KP; LAS float* sk = (LAS float*)(lds + LDS_SK);
    __syncthreads();
#pragma unroll
    for (int p = 0; p < 8; ++p) { const int row = p * 32 + (tid >> 4), ch = tid & 15; *(LAS u32x4*)(ldsK + row * KP + ch * 16) = pf[p]; *(LAS u32x4*)(ldsV + row * KP + ch * 16) = pf[8 + p]; }
    if (tid < 256) { const f32x4 p = qp.sk; sk[tid] = rsqrtf(((p[0] + p[1]) + (p[2] + p[3])) * (1.0f / 128.0f) + EPS); }
    const int qi = 16 * w + j; const size_t tokq = (size_t)b * SEQ + ((size_t)(128 * qb + qi) << sh) + r;
    bf16x8 qf[4];
#pragma unroll
    for (int s = 0; s < 4; ++s) qf[s] = qp.q[s];
    float sq; { const f32x4 p = qp.sq; sq = rsqrtf(((p[0] + p[1]) + (p[2] + p[3])) * (1.0f / 128.0f) + EPS) * 0.08838834764831845f; }
    __syncthreads();
    if (next_unit >= 0) attn_issue_loads(P, next_unit, pf, qp, tid);
    f32x4 S[9];
#pragma unroll
    for (int i = 0; i < 9; ++i) S[i] = (f32x4){0.f, 0.f, 0.f, 0.f};
    {
        const LAS unsigned char* kb0 = ldsK + (16 * w + j) * KP + 16 * g4;
#pragma unroll
        for (int s = 0; s < 4; ++s) {
            bf16x8 kf[9];
#pragma unroll
            for (int i = 0; i < 9; ++i) kf[i] = *(const LAS bf16x8*)(kb0 + 16 * i * KP + 64 * s);
            __builtin_amdgcn_sched_barrier(0);
#pragma unroll
            for (int i = 0; i < 9; ++i) S[i] = MFMA16(kf[i], qf[s], S[i]);
            __builtin_amdgcn_sched_barrier(0);
        }
    }
    float mx = -1e30f;
    const int tlo = max(j, -(kstart + 16 * w)), trange = min(j + 128, M - 1 - kstart - 16 * w) - tlo, tb4 = 4 * g4 - tlo;
    const float sq2 = sq * 1.4426950408889634f;
#pragma unroll
    for (int i = 0; i < 9; ++i) { const f32x4 skv = *(const LAS f32x4*)(sk + 16 * (w + i) + 4 * g4);
#pragma unroll
        for (int e = 0; e < 4; ++e) { const bool ok = (unsigned)(tb4 + 16 * i + e) <= (unsigned)trange;
            S[i][e] = ok ? S[i][e] * skv[e] * sq2 : -1e30f; mx = fmaxf(mx, S[i][e]); } }
    mx = fmaxf(mx, __shfl_xor(mx, 16)); mx = fmaxf(mx, __shfl_xor(mx, 32));
    float sum = 0.f;
#pragma unroll
    for (int i = 0; i < 9; ++i)
#pragma unroll
        for (int e = 0; e < 4; ++e) { S[i][e] = __builtin_amdgcn_exp2f(S[i][e] - mx); sum += S[i][e]; }
    sum += __shfl_xor(sum, 16); sum += __shfl_xor(sum, 32);
    f32x4 o[8];
#pragma unroll
    for (int c = 0; c < 8; ++c) o[c] = (f32x4){0.f, 0.f, 0.f, 0.f};
    const f32x4 zero4 = (f32x4){0.f, 0.f, 0.f, 0.f};
    {   LAS unsigned char* vb0 = ldsV + (16 * w + 4 * g4 + (j >> 2)) * KP + 8 * (j & 3);
#pragma unroll
        for (int pp = 0; pp < 5; ++pp) { const int ta = 2 * pp, tb = (pp < 4) ? ta + 1 : 8;
            bf16x8 vf[8];
#pragma unroll
            for (int c = 0; c < 8; ++c) vf[c] = tr_pair(vb0 + 16 * ta * KP + 32 * c, vb0 + 16 * tb * KP + 32 * c);
            const bf16x8 pf = pack_p(S[ta], (pp < 4) ? S[tb] : zero4);
            __builtin_amdgcn_sched_barrier(0);
#pragma unroll
            for (int c = 0; c < 8; ++c) o[c] = MFMA16(vf[c], pf, o[c]);
            __builtin_amdgcn_sched_barrier(0);
        }
    }
    const float inv = 1.0f / sum;
    bf16* op = P.og + (size_t)b * X_OG + (tokq * 12 + h) * 128 + 4 * g4;
#pragma unroll
    for (int c = 0; c < 8; ++c) { u32x2 wv; wv.x = cvt_pk_bf16(o[c][0] * inv, o[c][1] * inv); wv.y = cvt_pk_bf16(o[c][2] * inv, o[c][3] * inv); *(u32x2*)(op + 16 * c) = wv; }
    if (g4 == 0) P.lse[tokq * 12 + h] = mx * 0.6931471805599453f + __logf(sum);
}

__device__ __forceinline__ void attnB_unit(const AttnPtrs& P, LAS unsigned char* lds, int unit, int next_unit, u32x4 (&pf)[16], QPre& qp) {
    const int tid = threadIdx.x, lane = tid & 63, w = __builtin_amdgcn_readfirstlane(tid >> 6), j = lane & 15, g4 = lane >> 4;
    const int b = unit >> 7, hB = (unit >> 5) & 3, r = unit & 31, head = 12 + hB;
    const int rs = min(max(r - 4, 0), 24);
    const size_t tok0 = (size_t)b * SEQ + rs * 64;
    LAS unsigned char* kvb = lds + LDS_KV; LAS float* sk = (LAS float*)(lds + LDS_SK); LAS float* rpbL = (LAS float*)(lds + LDS_RPB);
    const int cb = w & 3, dh = w >> 2, qc = 16 * cb + j; const size_t tokq = (size_t)b * SEQ + r * 64 + qc;
    bf16x8 qf[4];
#pragma unroll
    for (int s = 0; s < 4; ++s) qf[s] = *(const bf16x8*)(P.Q + (size_t)b * X_QKV + tokq * D + head * 128 + 32 * s + 8 * g4);
    const f32x4 psq = *(const f32x4*)(P.ssq + ((size_t)head * T + tokq) * 4), psk = *(const f32x4*)(P.ssq + ((size_t)(16 + head) * T + tok0 + tid) * 4);
    __syncthreads();
#pragma unroll
    for (int p = 0; p < 16; ++p) { const int row = p * 32 + (tid >> 4), ch = tid & 15; *(LAS u32x4*)(kvb + row * KP + ch * 16) = pf[p]; }
    { const f32x4 p = psk; sk[tid] = rsqrtf(((p[0] + p[1]) + (p[2] + p[3])) * (1.0f / 128.0f) + EPS); }
    if (tid < 465) rpbL[tid] = P.rpb[hB * 465 + tid] * 1.4426950408889634f;
    float sq; { const f32x4 p = psq; sq = rsqrtf(((p[0] + p[1]) + (p[2] + p[3])) * (1.0f / 128.0f) + EPS) * 0.08838834764831845f; }
    __syncthreads();
    const int cbase = cb == 0 ? 0 : (cb == 1 ? 8 : (cb == 2 ? 24 : 32)), cs = min(max(qc - 8, 0), 48);
    f32x4 S[16];
#pragma unroll
    for (int tt = 0; tt < 16; ++tt) S[tt] = (f32x4){0.f, 0.f, 0.f, 0.f};
    {
        const LAS unsigned char* kb0 = kvb + (cbase + j) * KP + 16 * g4;
#pragma unroll
        for (int q = 0; q < 8; ++q) { const int s = q >> 1, hf = q & 1;
            bf16x8 kf[8];
#pragma unroll
            for (int t = 0; t < 8; ++t) { const int tt = 8 * hf + t; kf[t] = *(const LAS bf16x8*)(kb0 + ((tt >> 1) * 64 + 16 * (tt & 1)) * KP + 64 * s); }
            __builtin_amdgcn_sched_barrier(0);
#pragma unroll
            for (int t = 0; t < 8; ++t) S[8 * hf + t] = MFMA16(kf[t], qf[s], S[8 * hf + t]);
            __builtin_amdgcn_sched_barrier(0);
        }
    }
    __builtin_amdgcn_sched_barrier(0);
#pragma unroll
    for (int p = 0; p < 16; ++p) { const int row = p * 32 + (tid >> 4), ch = tid & 15; pf[p] = *(const u32x4*)(P.V + (size_t)b * X_QKV + (tok0 + row) * D + head * 128 + ch * 8); }
    __builtin_amdgcn_sched_barrier(0);
    float mx = -1e30f;
    const float sq2 = sq * 1.4426950408889634f;
    const int kb4 = cbase + 4 * g4 - cs;
    const LAS float* bl = rpbL + (rs - r + 7) * 31 + (cbase + 4 * g4 - qc + 15);
#pragma unroll
    for (int tt = 0; tt < 16; ++tt) { const int kr = tt >> 1, ct = tt & 1; const f32x4 skv = *(const LAS f32x4*)(sk + kr * 64 + cbase + 16 * ct + 4 * g4);
        float bv[4];
#pragma unroll
        for (int e = 0; e < 4; ++e) bv[e] = bl[kr * 31 + 16 * ct + e];
#pragma unroll
        for (int e = 0; e < 4; ++e) { const bool ok = (unsigned)(kb4 + 16 * ct + e) < 16u;
            const float sv = S[tt][e] * skv[e] * sq2 + bv[e];
            S[tt][e] = ok ? sv : -1e30f; mx = fmaxf(mx, S[tt][e]); } }
    mx = fmaxf(mx, __shfl_xor(mx, 16)); mx = fmaxf(mx, __shfl_xor(mx, 32));
    float sum = 0.f;
#pragma unroll
    for (int tt = 0; tt < 16; ++tt)
#pragma unroll
        for (int e = 0; e < 4; ++e) { S[tt][e] = __builtin_amdgcn_exp2f(S[tt][e] - mx); sum += S[tt][e]; }
    sum += __shfl_xor(sum, 16); sum += __shfl_xor(sum, 32);
    __syncthreads();
#pragma unroll
    for (int p = 0; p < 16; ++p) { const int row = p * 32 + (tid >> 4), ch = tid & 15; *(LAS u32x4*)(kvb + row * KP + ch * 16) = pf[p]; }
    if (next_unit >= 0) attnB_issue_k(P, next_unit - 1536, pf, tid);
    __syncthreads();
    f32x4 o[4];
#pragma unroll
    for (int c = 0; c < 4; ++c) o[c] = (f32x4){0.f, 0.f, 0.f, 0.f};
    {   LAS unsigned char* vb0 = kvb + (cbase + 4 * g4 + (j >> 2)) * KP + 128 * dh + 8 * (j & 3);
#pragma unroll
        for (int q = 0; q < 4; ++q) {
            bf16x8 vf[8];
#pragma unroll
            for (int t = 0; t < 8; ++t) { const int pr = 2 * q + (t >> 2); vf[t] = tr_pair(vb0 + 64 * pr * KP + 32 * (t & 3), vb0 + (64 * pr + 16) * KP + 32 * (t & 3)); }
            const bf16x8 p0 = pack_p(S[4 * q], S[4 * q + 1]), p1 = pack_p(S[4 * q + 2], S[4 * q + 3]);
            __builtin_amdgcn_sched_barrier(0);
#pragma unroll
            for (int t = 0; t < 8; ++t) o[t & 3] = MFMA16(vf[t], (t >> 2) ? p1 : p0, o[t & 3]);
            __builtin_amdgcn_sched_barrier(0);
        }
    }
    const float inv = 1.0f / sum;
    const float inv8 = inv * (float)(1 << OAB_SH);
    unsigned char* op = (unsigned char*)P.oab + (size_t)b * X_OAB8 + tokq * 1024 + 512 + hB * 128 + 64 * dh + 4 * g4;
#pragma unroll
    for (int c = 0; c < 4; ++c) { int t = __builtin_amdgcn_cvt_pk_fp8_f32(o[c][0] * inv8, o[c][1] * inv8, 0, false); t = __builtin_amdgcn_cvt_pk_fp8_f32(o[c][2] * inv8, o[c][3] * inv8, t, true); *(unsigned*)(op + 16 * c) = (unsigned)t; }
}

__device__ __forceinline__ void combine_phase(const AttnPtrs& P) {
    const int tid = threadIdx.x, lane = tid & 63, wave = tid >> 6, gw = blockIdx.x * 8 + wave, NGW = gridDim.x * 8;
    const int slot = lane >> 4, d8 = (lane & 15) * 8;
    for (int tok = (blockIdx.x & 7) * SEQ + (blockIdx.x >> 3) * (SEQ / (NGW / 64)) + wave * (SEQ / (NGW / 8)), tend = tok + SEQ / (NGW / 8); tok < tend; ++tok) {
        const float l0 = P.lse[(size_t)tok * 12 + slot], l1 = P.lse[(size_t)tok * 12 + 4 + slot], l2 = P.lse[(size_t)tok * 12 + 8 + slot];
        const float L = fmaxf(l0, fmaxf(l1, l2)); float w0 = __expf(l0 - L), w1 = __expf(l1 - L), w2 = __expf(l2 - L);
        const float inv = 1.0f / (w0 + w1 + w2); w0 *= inv; w1 *= inv; w2 *= inv;
        const bf16* base = P.og + (size_t)(tok >> 11) * X_OG + ((size_t)tok * 12 + slot) * 128 + d8;
        const u32x4 a = __builtin_nontemporal_load((const u32x4*)base), bq = __builtin_nontemporal_load((const u32x4*)(base + 4 * 128)), c = __builtin_nontemporal_load((const u32x4*)(base + 8 * 128));
        w0 *= (float)(1 << OAB_SH); w1 *= (float)(1 << OAB_SH); w2 *= (float)(1 << OAB_SH);
        int t0 = __builtin_amdgcn_cvt_pk_fp8_f32(w0 * bf_lo(a.x) + w1 * bf_lo(bq.x) + w2 * bf_lo(c.x), w0 * bf_hi(a.x) + w1 * bf_hi(bq.x) + w2 * bf_hi(c.x), 0, false);
        t0 = __builtin_amdgcn_cvt_pk_fp8_f32(w0 * bf_lo(a.y) + w1 * bf_lo(bq.y) + w2 * bf_lo(c.y), w0 * bf_hi(a.y) + w1 * bf_hi(bq.y) + w2 * bf_hi(c.y), t0, true);
        int t1 = __builtin_amdgcn_cvt_pk_fp8_f32(w0 * bf_lo(a.z) + w1 * bf_lo(bq.z) + w2 * bf_lo(c.z), w0 * bf_hi(a.z) + w1 * bf_hi(bq.z) + w2 * bf_hi(c.z), 0, false);
        t1 = __builtin_amdgcn_cvt_pk_fp8_f32(w0 * bf_lo(a.w) + w1 * bf_lo(bq.w) + w2 * bf_lo(c.w), w0 * bf_hi(a.w) + w1 * bf_hi(bq.w) + w2 * bf_hi(c.w), t1, true);
        u32x2 o8; o8.x = (unsigned)t0; o8.y = (unsigned)t1;
        *(u32x2*)((unsigned char*)P.oab + (size_t)(tok >> 11) * X_OAB8 + (size_t)tok * 1024 + slot * 128 + d8) = o8;
    }
}
constexpr int N_PHASES = 8;
__device__ __forceinline__ void grid_bar(unsigned* ctl, unsigned gen) {
    asm volatile("s_waitcnt vmcnt(0)" ::: "memory");
    __syncthreads();
    if (threadIdx.x == 0) {
        const unsigned x = blockIdx.x & 7u, nloc = gridDim.x >> 3;
        unsigned* xsub = ctl + 64 * (1 + x); unsigned* xgen = ctl + 64 * (9 + x); unsigned* top = ctl + 64 * 17; unsigned* topgen = ctl + 64 * 18;
        __builtin_amdgcn_fence(__ATOMIC_RELEASE, "agent");
        asm volatile("s_waitcnt vmcnt(0)" ::: "memory");
        const unsigned old = __hip_atomic_fetch_add(xsub, 1u, __ATOMIC_RELAXED, __HIP_MEMORY_SCOPE_AGENT);
        if (old + 1u == gen * nloc) {
            const unsigned og = __hip_atomic_fetch_add(top, 1u, __ATOMIC_RELAXED, __HIP_MEMORY_SCOPE_AGENT);
            if (og + 1u == gen * 8u) __hip_atomic_store(topgen, gen, __ATOMIC_RELAXED, __HIP_MEMORY_SCOPE_AGENT);
            else while (__hip_atomic_load(topgen, __ATOMIC_RELAXED, __HIP_MEMORY_SCOPE_AGENT) < gen) __builtin_amdgcn_s_sleep(1);
            __hip_atomic_store(xgen, gen, __ATOMIC_RELAXED, __HIP_MEMORY_SCOPE_AGENT);
        } else {
            while (__hip_atomic_load(xgen, __ATOMIC_RELAXED, __HIP_MEMORY_SCOPE_AGENT) < gen) __builtin_amdgcn_s_sleep(1);
        }
        __builtin_amdgcn_fence(__ATOMIC_ACQUIRE, "agent");
        asm volatile("s_waitcnt vmcnt(0)" ::: "memory");
    }
    __syncthreads();
}
__device__ __forceinline__ void group_bar(unsigned* ctl, unsigned gen) {
    asm volatile("s_waitcnt vmcnt(0)" ::: "memory");
    __syncthreads();
    if (threadIdx.x == 0) {
        unsigned* cnt = ctl + 64 * (20 + (blockIdx.x & 7u)); const unsigned target = gen * (gridDim.x >> 3);
        __builtin_amdgcn_fence(__ATOMIC_RELEASE, "agent");
        asm volatile("s_waitcnt vmcnt(0)" ::: "memory");
        __hip_atomic_fetch_add(cnt, 1u, __ATOMIC_RELAXED, __HIP_MEMORY_SCOPE_AGENT);
        while (__hip_atomic_load(cnt, __ATOMIC_RELAXED, __HIP_MEMORY_SCOPE_AGENT) < target) __builtin_amdgcn_s_sleep(1);
        __builtin_amdgcn_fence(__ATOMIC_ACQUIRE, "agent");
        asm volatile("s_waitcnt vmcnt(0)" ::: "memory");
    }
    __syncthreads();
}
__global__ void __launch_bounds__(512) fwd_megakernel(Args a) {
    __shared__ __attribute__((aligned(16))) unsigned char lds_raw[LDS_BYTES];
    LAS unsigned char* lds = (LAS unsigned char*)lds_raw;
    unsigned char* ws = a.ws; unsigned char* ob = (unsigned char*)a.out;
    const int lo = a.ph_lo, hi = a.ph_hi, G = gridDim.x; int nbar = 0, ngbar = 0;
#ifdef ONLY
#define IN(k) ((k) == ONLY && lo <= (k) && (k) < hi)
#else
#define IN(k) (lo <= (k) && (k) < hi)
#endif
#if MK_MULTI
#define GSEAM(k) do { } while (0)
#define SEAM(k) do { } while (0)
#else
#define GSEAM(k) do { if (IN(k) && IN((k) + 1)) { group_bar((unsigned*)ws, (unsigned)(++ngbar)); } } while (0)
#ifndef BARX
#define BARX 1
#endif
#define SEAM(k) do { if (IN(k) && IN((k) + 1)) { if ((k) == 0) cg::this_grid().sync(); else { for (int bx_ = 0; bx_ < BARX; ++bx_) grid_bar((unsigned*)ws, (unsigned)(++nbar)); } } } while (0)
#endif
    bf16* const Qb = (bf16*)(ws + WS_Q); bf16* const Kb = (bf16*)(ws + WS_K); bf16* const Vb = (bf16*)(ws + WS_V); bf16* const Gb = (bf16*)(ws + WS_G);
    float* const ssq = (float*)(ws + WS_SSQ); float* const hp = (float*)(ws + WS_HP);
    bf16* const oab = (bf16*)(ob + OUT_OAB);

    const int vid = (int)blockIdx.x;
#ifndef DUP
#define DUP -1
#endif
#define REP(k) _Pragma("unroll 1") for (int rep_ = 0; rep_ < ((k) == DUP ? (hi >> 2) : 1); ++rep_)
    if (IN(0)) { if (blockIdx.x == 0) { for (int i = threadIdx.x; i < 2048; i += 512) __hip_atomic_store((unsigned*)ws + i, 0u, __ATOMIC_RELAXED, __HIP_MEMORY_SCOPE_AGENT); }
        REP(0) { p0_prologue(a, lds); __syncthreads(); } }
    SEAM(0);
    if (IN(1)) {
        pg8::Gemm g{(const bf16*)(ob + OUT_XN8), (const bf16*)(ws + WS_WIN), T, DIN, D / 2, X_XN8}; pg8::StaticOrder S; S.init(T, DIN, G, vid, DUP == 1);
        EpiProj E{ws};
        pg8::gemm_phase<EpiProj, pg8::StaticOrder, true, true, 0, true>(lds, g, S, E);
    }
    GSEAM(1);
    const AttnPtrs AP{Qb, Kb, Vb, ssq, (bf16*)ob, (float*)(ws + WS_LSE), oab, a.in[8]};
    if (IN(2)) {
        {
            constexpr int RP = (DUP == 2) ? 2 : 1;
            const int nA = 1536 / G, nB = 1024 / G, xq = vid & 7, jq = vid >> 3, perX = G >> 3;
#define UNIT_A(n) (xq * (1536 / 8) + jq + perX * ((n) % nA))
#define UNIT_B(n) (1536 + xq * (1024 / 8) + jq + perX * ((n) % nB))
            u32x4 pf[16]; QPre qp;
            attn_issue_loads(AP, UNIT_A(0), pf, qp, threadIdx.x);
#pragma unroll 1
            for (int n = 0; n < RP * nA; ++n) { const int u = UNIT_A(n), un = (n + 1 < RP * nA) ? UNIT_A(n + 1) : UNIT_B(0); attnA_unit(AP, lds, u, un, pf, qp); }
#pragma unroll 1
            for (int n = 0; n < RP * nB; ++n) { const int u = UNIT_B(n), un = (n + 1 < RP * nB) ? UNIT_B(n + 1) : -1; attnB_unit(AP, lds, u - 1536, un, pf, qp); }
#undef UNIT_A
#undef UNIT_B
            __syncthreads(); }
    }
    GSEAM(2);
    if (IN(3)) { combine_phase(AP); }
    GSEAM(3);
    if (IN(4)) {
        pg8::Gemm g{oab, (const bf16*)(ws + WS_WP), T, D, 512, X_OAB8};     pg8::StaticOrder S; S.init(T, D, G, vid, DUP == 4);
        EpiMix E{(const unsigned char*)(ws + WS_G), Kb};
        pg8::gemm_phase<EpiMix, pg8::StaticOrder, true, true, 0, true>(lds, g, S, E);
    }
    GSEAM(4);
    if (IN(5)) {
        pg8::Gemm g{Kb, (const bf16*)(ws + WS_WOUT), T, D, D / 2, X_MIX8};     pg8::StaticOrder S; S.init(T, D, G, vid, DUP == 5);
        EpiRes1 E{a.in[0], a.out, Qb, hp};
        pg8::gemm_phase<EpiRes1, pg8::StaticOrder, true, true, 0, true>(lds, g, S, E);
    }
    GSEAM(5);
    if (IN(6)) {
        pg8::Gemm g{Qb, (const bf16*)(ws + WS_WUP), T, DFF, D, X_QKV * 2}; pg8::StaticOrder S; S.init(T, DFF, G, vid, DUP == 6);
        LAS float* rsT = (LAS float*)(lds + 131072);
        { pg8::Unit uu; for (int i = 0; S.next(i, uu); ++i) if (threadIdx.x < 256) { const f32x4* pp = (const f32x4*)(hp + (size_t)(uu.pm * 256 + threadIdx.x) * 32); f32x4 s = pp[0];
#pragma unroll
              for (int q = 1; q < 8; ++q) s += pp[q];
              rsT[uu.idx * 256 + threadIdx.x] = rsqrtf(((s[0] + s[1]) + (s[2] + s[3])) * (1.0f / D) + EPS); }
          __syncthreads(); }
        EpiUp E{rsT, (bf16*)(ws + WS_U)};
        pg8::gemm_phase<EpiUp, pg8::StaticOrder, true, true>(lds, g, S, E);
    }
    GSEAM(6);
    if (IN(7)) {
        pg8::Gemm g{(const bf16*)(ws + WS_U), (const bf16*)(ws + WS_WDN), T, D, DFF, X_U * 2}; pg8::StaticOrder S; S.init(T, D, G, vid);
        EpiRes2 E{a.out, Qb};
        pg8::gemm_phase<EpiRes2, pg8::StaticOrder, true, true>(lds, g, S, E);
    }
#undef IN
#undef SEAM
#undef GSEAM
}

extern "C" void kernel_launch(void* const* d_in, const int* in_sizes, int n_in, void* d_out, int out_size, void* d_ws, size_t ws_size, hipStream_t stream) {
    static int grid = 0;
    if (grid == 0) {
        if (n_in != 15 || in_sizes[0] != T * D || out_size != T * D || ws_size < WS_END) { fprintf(stderr, "kernel_launch: unexpected shapes (n_in %d, x %d, out %d, ws %zu)\n", n_in, n_in > 0 ? in_sizes[0] : -1, out_size, ws_size); grid = -1; return; }
        int dev = 0, cus = 0, per_cu = 0;
        hipGetDevice(&dev); hipDeviceGetAttribute(&cus, hipDeviceAttributeMultiprocessorCount, dev);
        hipOccupancyMaxActiveBlocksPerMultiprocessor(&per_cu, (const void*)fwd_megakernel, 512, 0);
        if (per_cu < 1) { fprintf(stderr, "kernel_launch: occupancy query says %d blocks per CU\n", per_cu); per_cu = 1; }
        (void)hipGetLastError();
        grid = cus * per_cu;
        if (grid > 256) grid = 256;
        if (grid != 256) { fprintf(stderr, "kernel_launch: this kernel's unit orders need exactly 256 resident workgroups (got %d)\n", grid); grid = -1; return; }
        fprintf(stderr, "kernel_launch: grid %d (cus %d, per_cu %d)\n", grid, cus, per_cu);
    }
    if (grid < 0) return;
    Args a{};
    for (int i = 0; i < 15; ++i) a.in[i] = (const float*)d_in[i];
    a.out = (float*)d_out; a.ws = (unsigned char*)d_ws;
#if MK_MULTI
    for (int p = 0; p < N_PHASES; ++p) { a.ph_lo = p; a.ph_hi = p + 1; hipLaunchKernelGGL(fwd_megakernel, dim3(grid), dim3(512), 0, stream, a); }
#else
    a.ph_lo = 0; a.ph_hi = N_PHASES;
    void* args[] = {&a};
    hipError_t e = hipLaunchCooperativeKernel((const void*)fwd_megakernel, dim3(grid), dim3(512), args, 0, stream);
    if (e != hipSuccess) fprintf(stderr, "kernel_launch: cooperative launch failed: %s (grid %d)\n", hipGetErrorString(e), grid);
#endif
}
```

```cpp
#include <hip/hip_runtime.h>
#include <hip/hip_cooperative_groups.h>
#include <cstdio>
#include <cstdint>
namespace cg = cooperative_groups;
#ifndef MK_MULTI
#define MK_MULTI 0
#endif
namespace pg8 {
#define PG8_LAS __attribute__((address_space(3)))
typedef unsigned short bf16_t;
typedef short bf16x8 __attribute__((ext_vector_type(8)));
typedef float f32x4 __attribute__((ext_vector_type(4)));
typedef unsigned u32x4 __attribute__((ext_vector_type(4)));
typedef int i32x8 __attribute__((ext_vector_type(8)));
constexpr int BM = 256, BK = 64, HALF = 128, HTB = HALF * BK * 2  , STAGE_BYTES = 8 * HTB, NXCD = 8, WGM = 2;

__host__ __device__ __forceinline__ int lds_byte(int r, int c) { const int st = (r >> 4) * 2 + (c >> 5), rr = r & 15, cc = c & 31, ob = rr * 64 + cc * 2; return st * 1024 + (ob ^ (((ob >> 9) & 1) << 5)); }
__host__ __device__ __forceinline__ void stage_rc(int b, int& R, int& C) { const int st = b / 1024, sb = b % 1024, swz = sb ^ (((sb >> 9) & 1) << 5); R = (st >> 1) * 16 + swz / 64; C = (st & 1) * 32 + (swz % 64) / 2; }
__host__ __device__ __forceinline__ int perm32(int rho) { const int n = rho >> 4, i = rho & 15; return 8 * (i >> 2) + 4 * n + (i & 3); }

struct Unit { int pm, pn, idx; };
struct Gemm { const bf16_t* A; const bf16_t* Bt; int M, N, K; size_t a_extra; };

struct StaticOrder {
    int nM, nN, nwg, G, c, dup;
    __host__ __device__ void init(int M, int N, int G_, int c_, int dup_ = 0) { nM = M / BM; nN = N / BM; nwg = nM * nN; G = G_; c = c_; dup = dup_; }
    __host__ __device__ bool next(int i, Unit& u) const {
        const long L = (long)(i >> dup) * G + c; if (L >= nwg) return false;
        int wgid = (int)L; { const int q = nwg / NXCD, r = nwg % NXCD, xcd = wgid % NXCD, off = wgid / NXCD; wgid = (xcd < r ? xcd * (q + 1) : r * (q + 1) + (xcd - r) * q) + off; }
        const int nig = WGM * nN, gid = wgid / nig, fm = gid * WGM, gsz = (nM - fm) < WGM ? (nM - fm) : WGM;
        u.pm = fm + ((wgid % nig) % gsz); u.pn = (wgid % nig) / gsz; u.idx = i >> dup; return true;
    }
    __device__ __forceinline__ void a_ready(const Unit&) const {}
    __device__ __forceinline__ void done(const Unit&) const {}
};
__device__ __forceinline__ unsigned cvt_pk_bf16(float lo, float hi) { unsigned r; asm volatile("v_cvt_pk_bf16_f32 %0, %1, %2" : "=v"(r) : "v"(lo), "v"(hi)); return r; }
template <class Epi, class Sched, bool ALIGN_EPI = false, bool SP2 = false, int AUXA = 0, bool F8 = false>
__device__ __forceinline__ void gemm_phase(PG8_LAS unsigned char* lds, const Gemm g, const Sched& S, const Epi& E) {
    const int tid = threadIdx.x, wid = __builtin_amdgcn_readfirstlane(tid >> 6), lane = tid & 63, wr = wid >> 2, wc = wid & 3, fr = lane & 15, fq = lane >> 4;
    const int K = g.K, nt = K / BK;
    unsigned voffA[2], voffB[2];
#pragma unroll
    for (int i = 0; i < 2; ++i) { int R, C; stage_rc(tid * 16 + i * 8192, R, C); const int Rb = Epi::PERM ? ((R & ~31) + perm32(R & 31)) : R;
        voffA[i] = (unsigned)(R * K + C) * 2u; voffB[i] = (unsigned)(Rb * K + C) * 2u; }
    const size_t kstep = (size_t)(BK * 2);
    const size_t hstep = (size_t)HALF * K * 2;
    const size_t tstep = 2 * hstep;
    const unsigned ldsw = (unsigned)wid * 1024u;
    const int aoff = lds_byte(wr * 64 + fr, fq * 8), boff = lds_byte(wc * 32 + fr, fq * 8);
#define PG8_SA(b, h) (((b) * 2 + (h)) * HTB)
#define PG8_SB(b, h) ((4 + (b) * 2 + (h)) * HTB)
#define PG8_STAGE_X(bufoff, gbase, voff, aux) do { _Pragma("unroll") for (int _i = 0; _i < 2; ++_i) \
        __builtin_amdgcn_global_load_lds((const unsigned*)((const char*)(gbase) + (voff)[_i]), (PG8_LAS unsigned*)(lds + (bufoff) + ldsw + _i * 8192), 16, 0, aux); } while (0)
#define PG8_STAGE(bufoff, gbase, voff) do { if constexpr (AUXA != 0) { if ((bufoff) < 4 * HTB) PG8_STAGE_X(bufoff, gbase, voff, AUXA); else PG8_STAGE_X(bufoff, gbase, voff, 0); } else PG8_STAGE_X(bufoff, gbase, voff, 0); } while (0)
#define PG8_LDA(dst, b, h) do { _Pragma("unroll") for (int m = 0; m < 4; ++m) _Pragma("unroll") for (int k = 0; k < 2; ++k) dst[m].hf[k] = *(const PG8_LAS bf16x8*)(lds + PG8_SA(b, h) + aoff + m * 2048 + k * 1024); } while (0)
#define PG8_LDB(dst, b, h) do { _Pragma("unroll") for (int n = 0; n < 2; ++n) _Pragma("unroll") for (int k = 0; k < 2; ++k) dst[n].hf[k] = *(const PG8_LAS bf16x8*)(lds + PG8_SB(b, h) + boff + n * 2048 + k * 1024); } while (0)
#define PG8_MMA(ai, bj, At, Bt) do { __builtin_amdgcn_s_setprio(1); if constexpr (F8) { _Pragma("unroll") for (int m = 0; m < 4; ++m) _Pragma("unroll") for (int n = 0; n < 2; ++n) \
        asm volatile("v_mfma_scale_f32_16x16x128_f8f6f4 %0, %1, %2, %0, %3, %3 op_sel_hi:[0,0,0]" : "+v"(acc[ai][bj][m][n]) : "v"(Bt[n].w), "v"(At[m].w), "v"(sc127)); } else { \
        _Pragma("unroll") for (int m = 0; m < 4; ++m) _Pragma("unroll") for (int n = 0; n < 2; ++n) _Pragma("unroll") for (int k = 0; k < 2; ++k) \
        acc[ai][bj][m][n] = __builtin_amdgcn_mfma_f32_16x16x32_bf16(Bt[n].hf[k], At[m].hf[k], acc[ai][bj][m][n], 0, 0, 0); } __builtin_amdgcn_s_setprio(0); } while (0)
#define PG8_WAIT_V(n) asm volatile("s_waitcnt vmcnt(" #n ")" ::: "memory")
#define PG8_WAIT_L(n) asm volatile("s_waitcnt lgkmcnt(" #n ")" ::: "memory")
#define PG8_BAR __builtin_amdgcn_s_barrier()
#define PG8_SCHED __builtin_amdgcn_sched_barrier(0)
    Unit cur, nxt; int ui = 0;
    if (!S.next(0, cur)) return;
    f32x4 acc[2][2][4][2];
    if constexpr (Epi::INIT) { E.init(acc, cur, wr, wc, fr, fq); } else {
#pragma unroll
    for (int a = 0; a < 2; ++a)
#pragma unroll
        for (int b = 0; b < 2; ++b)
#pragma unroll
            for (int m = 0; m < 4; ++m)
#pragma unroll
                for (int n = 0; n < 2; ++n) acc[a][b][m][n] = (f32x4){0.f, 0.f, 0.f, 0.f};
    }
    union Frag { bf16x8 hf[2]; pg8::i32x8 w; };
    Frag At[4], B0[2], B1[2];
    const int sc127 = 127;
    const char* cA = (const char*)g.A + (size_t)cur.pm * tstep + (size_t)(cur.pm >> 3) * g.a_extra; const char* cB = (const char*)g.Bt + (size_t)cur.pn * tstep;
    S.a_ready(cur);
    if constexpr (SP2) {
        PG8_STAGE(PG8_SB(0, 0), cB, voffB); PG8_STAGE(PG8_SB(0, 1), cB + hstep, voffB); PG8_STAGE(PG8_SA(0, 0), cA, voffA); PG8_STAGE(PG8_SA(0, 1), cA + hstep, voffA);
        if (wr == 1) PG8_BAR;
        PG8_WAIT_V(2); PG8_BAR;
        PG8_STAGE(PG8_SB(1, 0), cB + kstep, voffB); PG8_STAGE(PG8_SA(1, 0), cA + kstep, voffA); PG8_STAGE(PG8_SB(1, 1), cB + hstep + kstep, voffB);
        PG8_WAIT_V(6); PG8_BAR;
    } else {
        PG8_STAGE(PG8_SB(0, 0), cB, voffB); PG8_STAGE(PG8_SA(0, 0), cA, voffA); PG8_STAGE(PG8_SB(0, 1), cB + hstep, voffB); PG8_STAGE(PG8_SA(0, 1), cA + hstep, voffA);
        if (wr == 1) PG8_BAR;
        PG8_WAIT_V(4); PG8_BAR;
        PG8_STAGE(PG8_SB(1, 0), cB + kstep, voffB); PG8_STAGE(PG8_SA(1, 0), cA + kstep, voffA); PG8_STAGE(PG8_SB(1, 1), cB + hstep + kstep, voffB);
        PG8_WAIT_V(6); PG8_BAR;
    }
    for (;;) {
        const bool has_next = S.next(ui + 1, nxt);
        const char* nA = has_next ? (const char*)g.A + (size_t)nxt.pm * tstep + (size_t)(nxt.pm >> 3) * g.a_extra : cA; const char* nB = has_next ? (const char*)g.Bt + (size_t)nxt.pn * tstep : cB;
        for (int t = 0; t < nt; t += 2) {
            const bool last = (t == nt - 2);
            const char* a1 = cA + (size_t)(t + 1) * kstep;
            const char* a2 = last ? nA : cA + (size_t)(t + 2) * kstep; const char* b2 = last ? nB : cB + (size_t)(t + 2) * kstep;
            const char* a3 = a2 + kstep; const char* b3 = b2 + kstep;
            if (last && has_next) S.a_ready(nxt);
            if constexpr (Epi::MIDK) { if (t == (nt >> 1)) E.mid(acc, cur, wr, wc, fr, fq); }
            if constexpr (SP2) {
            PG8_LDB(B0, 0, 0); PG8_LDB(B1, 0, 1); PG8_SCHED; PG8_LDA(At, 0, 0); PG8_STAGE(PG8_SA(1, 1), a1 + hstep, voffA);
            PG8_WAIT_V(8); PG8_WAIT_L(0); PG8_BAR; PG8_MMA(0, 0, At, B0); PG8_MMA(0, 1, At, B1); PG8_BAR; PG8_SCHED;
            PG8_LDA(At, 0, 1); PG8_STAGE(PG8_SB(0, 0), b2, voffB); PG8_STAGE(PG8_SB(0, 1), b2 + hstep, voffB); PG8_STAGE(PG8_SA(0, 0), a2, voffA);
            PG8_WAIT_V(8); PG8_WAIT_L(0); PG8_BAR; PG8_MMA(1, 0, At, B0); PG8_MMA(1, 1, At, B1); PG8_BAR; PG8_SCHED;
            PG8_LDB(B0, 1, 0); PG8_LDB(B1, 1, 1); PG8_SCHED; PG8_LDA(At, 1, 0); PG8_STAGE(PG8_SA(0, 1), a2 + hstep, voffA);
            PG8_WAIT_V(8); PG8_WAIT_L(0); PG8_BAR; PG8_MMA(0, 0, At, B0); PG8_MMA(0, 1, At, B1); PG8_BAR; PG8_SCHED;
            PG8_LDA(At, 1, 1); PG8_STAGE(PG8_SB(1, 0), b3, voffB); PG8_STAGE(PG8_SB(1, 1), b3 + hstep, voffB); PG8_STAGE(PG8_SA(1, 0), a3, voffA);
            PG8_WAIT_V(8); PG8_WAIT_L(0); PG8_BAR; PG8_MMA(1, 0, At, B0); PG8_MMA(1, 1, At, B1); PG8_BAR; PG8_SCHED;
            } else {
            PG8_LDB(B0, 0, 0); PG8_SCHED; PG8_LDA(At, 0, 0); PG8_STAGE(PG8_SA(1, 1), a1 + hstep, voffA);
            PG8_WAIT_L(8); PG8_BAR; PG8_WAIT_L(0); PG8_MMA(0, 0, At, B0); PG8_BAR; PG8_SCHED;
            PG8_LDB(B1, 0, 1); PG8_STAGE(PG8_SB(0, 0), b2, voffB);
            PG8_BAR; PG8_WAIT_L(0); PG8_MMA(0, 1, At, B1); PG8_BAR;
            PG8_LDA(At, 0, 1); PG8_STAGE(PG8_SA(0, 0), a2, voffA);
            PG8_BAR; PG8_WAIT_L(0); PG8_MMA(1, 0, At, B0); PG8_BAR; PG8_SCHED;
            PG8_STAGE(PG8_SB(0, 1), b2 + hstep, voffB);
            PG8_WAIT_V(6); PG8_BAR; PG8_MMA(1, 1, At, B1); PG8_BAR;
            PG8_LDB(B0, 1, 0); PG8_SCHED; PG8_LDA(At, 1, 0); PG8_STAGE(PG8_SA(0, 1), a2 + hstep, voffA);
            PG8_WAIT_L(8); PG8_BAR; PG8_WAIT_L(0); PG8_MMA(0, 0, At, B0); PG8_BAR; PG8_SCHED;
            PG8_LDB(B1, 1, 1); PG8_STAGE(PG8_SB(1, 0), b3, voffB);
            PG8_BAR; PG8_WAIT_L(0); PG8_MMA(0, 1, At, B1); PG8_BAR;
            PG8_LDA(At, 1, 1); PG8_STAGE(PG8_SA(1, 0), a3, voffA);
            PG8_BAR; PG8_WAIT_L(0); PG8_MMA(1, 0, At, B0); PG8_BAR; PG8_SCHED;
            PG8_STAGE(PG8_SB(1, 1), b3 + hstep, voffB);
            PG8_WAIT_V(6); PG8_BAR; PG8_MMA(1, 1, At, B1); PG8_BAR;
            }
        }
        if constexpr (F8) { asm volatile("s_nop 15\n\ts_nop 15\n\ts_nop 15" ::: "memory"); }
        if constexpr (ALIGN_EPI) { if (wr == 0) PG8_BAR; }
        if constexpr (!Epi::AFTER_DRAIN) { E(acc, cur, wr, wc, fr, fq); S.done(cur); }
        if (!has_next) break;
        if constexpr (Epi::INIT) { E.init(acc, nxt, wr, wc, fr, fq); } else {
#pragma unroll
        for (int a = 0; a < 2; ++a)
#pragma unroll
            for (int b = 0; b < 2; ++b)
#pragma unroll
                for (int m = 0; m < 4; ++m)
#pragma unroll
                    for (int n = 0; n < 2; ++n) acc[a][b][m][n] = (f32x4){0.f, 0.f, 0.f, 0.f};
        }
        cur = nxt; cA = nA; cB = nB; ++ui;
        if constexpr (ALIGN_EPI) { if (wr == 1) PG8_BAR; }
    }
    PG8_WAIT_V(0);
    if constexpr (!ALIGN_EPI) { if (wr == 0) PG8_BAR; }
    PG8_BAR;
    if constexpr (Epi::AFTER_DRAIN) { E.fused(acc, cur, wr, wc, fr, fq, lds, wid, lane); S.done(cur); }
#undef PG8_SA
#undef PG8_SB
#undef PG8_STAGE
#undef PG8_STAGE_X
#undef PG8_LDA
#undef PG8_LDB
#undef PG8_MMA
#undef PG8_WAIT_V
#undef PG8_WAIT_L
#undef PG8_BAR
#undef PG8_SCHED
}
}
#define LAS __attribute__((address_space(3)))
typedef unsigned short bf16;
typedef short bf16x8 __attribute__((ext_vector_type(8)));
typedef short s16x4 __attribute__((ext_vector_type(4)));
typedef float f32x4 __attribute__((ext_vector_type(4)));
typedef float f32x2 __attribute__((ext_vector_type(2)));
typedef unsigned u32x4 __attribute__((ext_vector_type(4)));
typedef unsigned u32x2 __attribute__((ext_vector_type(2)));
typedef __bf16 bf16x2v __attribute__((ext_vector_type(2)));
__device__ __forceinline__ unsigned cvt_pk_bf16(float lo, float hi) { const f32x2 v = {lo, hi}; return __builtin_bit_cast(unsigned, __builtin_convertvector(v, bf16x2v)); }

constexpr int T = 16384, SEQ = 2048, D = 2048, DIN = 10240, DFF = 8192;
constexpr float EPS = 1e-6f;
constexpr size_t MiB = 1u << 20;
constexpr size_t WS_ROPE = 1 * MiB;
constexpr size_t WS_SSQ = 2 * MiB;
constexpr size_t WS_LSE = 10 * MiB;
constexpr size_t WS_HP = 11 * MiB;
constexpr size_t WS_SMALL = 13 * MiB;
constexpr size_t WS_WIN = 14 * MiB;
constexpr size_t WS_WP = 54 * MiB;
constexpr size_t WS_WOUT = 58 * MiB;
constexpr size_t WS_WUP = 66 * MiB;
constexpr size_t WS_WDN = 98 * MiB;
constexpr size_t WS_Q = 130 * MiB, WS_K = 138 * MiB, WS_V = 146 * MiB, WS_G = 154 * MiB, WS_U = 138 * MiB, WS_END = 450 * MiB;
constexpr int WOUT_SH = 6, MIX_SH = 4;
constexpr size_t X_MIX8 = 40 * MiB - (size_t)SEQ * 2048;
constexpr int WP_SH = 5, OAB_SH = 4;
constexpr size_t X_OAB8 = 16 * MiB - (size_t)SEQ * 1024;
constexpr size_t X_G8 = 40 * MiB - (size_t)SEQ * 4096;
constexpr int WG_SH = 6;
constexpr size_t WS_WG8 = WS_WIN + 24 * MiB;
constexpr size_t OUT_XN8 = 12 * MiB, X_XN8 = 16 * MiB - (size_t)SEQ * 2048;
constexpr size_t ARENA_EL = 40 * MiB / 2;
constexpr size_t X_QKV = ARENA_EL - (size_t)SEQ * 2048, X_G = ARENA_EL - (size_t)SEQ * 4096, X_U = ARENA_EL - (size_t)SEQ * 8192;
constexpr size_t OUT_OAB = 8 * MiB, OUTB_EL = 16 * MiB / 2;
constexpr size_t X_XN = OUTB_EL - (size_t)SEQ * 2048, X_OG = OUTB_EL - (size_t)SEQ * 1536, X_OAB = OUTB_EL - (size_t)SEQ * 1024;
constexpr int KP = 272;
constexpr int LDS_KV = 0, LDS_SK = 139264, LDS_RPB = 141312, LDS_BYTES = 147456;

__device__ __forceinline__ float bf_lo(unsigned u) { return __uint_as_float(u << 16); }
__device__ __forceinline__ float bf_hi(unsigned u) { return __uint_as_float(u & 0xffff0000u); }
__device__ __forceinline__ float wave_sum(float v) {
#pragma unroll
    for (int o = 1; o < 64; o <<= 1) v += __shfl_xor(v, o);
    return v;
}

struct Args { const float* in[15]; float* out; unsigned char* ws; int ph_lo, ph_hi; };

constexpr int TP = 136;
template <bool PERMQK, int F8 = -1>
__device__ __forceinline__ void p0_item64(const float* __restrict__ W, int N, bf16* __restrict__ WT, int ldt, int col_off, const float* __restrict__ g, LAS unsigned char* til, int item, int lane) {
    const int nblk = N / 64, kb = item / nblk, nb = item % nblk, k0 = 64 * kb, n0 = 64 * nb;
    const int l16 = lane & 15, lr = lane >> 4, sc = 4 * l16;
    const bool perm = PERMQK && n0 < 4096;
    int srccol = n0 + sc;
    if (perm) { const int hb = n0 & ~127, hp = (n0 >> 6) & 1; srccol = hb + (sc < 32 ? 32 * hp + sc : 64 + 32 * hp + (sc - 32)); }
    f32x4 v[16];
#pragma unroll
    for (int it = 0; it < 16; ++it) v[it] = __builtin_nontemporal_load((const f32x4*)(W + (size_t)(k0 + 4 * it + lr) * N + srccol));
#pragma unroll
    for (int it = 0; it < 16; ++it) { const int kk = 4 * it + lr; const float gs = (g ? g[k0 + kk] : 1.0f) * (float)(1 << (F8 >= 0 ? F8 : 0));
        u32x2 o; o.x = cvt_pk_bf16(v[it][0] * gs, v[it][1] * gs); o.y = cvt_pk_bf16(v[it][2] * gs, v[it][3] * gs);
        *(LAS u32x2*)(til + kk * TP + sc * 2) = o; }
    const int i = lane & 15, gq = lane >> 4, q = i >> 2, p = i & 3;
#pragma unroll
    for (int nbk = 0; nbk < 4; ++nbk) {
        const int colp = perm ? (8 * nbk + 4 * (p & 1) + 32 * (p >> 1)) : (16 * nbk + 4 * p);
        const int drow = perm ? (n0 + 2 * (8 * nbk + (i & 7)) + (i >> 3)) : (n0 + 16 * nbk + i);
#pragma unroll
        for (int k2 = 0; k2 < 2; ++k2) {
            LAS unsigned char* a0 = til + (32 * k2 + 8 * gq + q) * TP + colp * 2;
            const s16x4 lo = __builtin_amdgcn_ds_read_tr16_b64_v4i16((LAS s16x4*)a0), hi = __builtin_amdgcn_ds_read_tr16_b64_v4i16((LAS s16x4*)(a0 + 4 * TP));
            const bf16x8 ov = __builtin_shufflevector(lo, hi, 0, 1, 2, 3, 4, 5, 6, 7);
            if constexpr (F8 >= 0) { const u32x4 w = __builtin_bit_cast(u32x4, ov); u32x2 o8;
                int t0 = __builtin_amdgcn_cvt_pk_fp8_f32(bf_lo(w.x), bf_hi(w.x), 0, false); t0 = __builtin_amdgcn_cvt_pk_fp8_f32(bf_lo(w.y), bf_hi(w.y), t0, true);
                int t1 = __builtin_amdgcn_cvt_pk_fp8_f32(bf_lo(w.z), bf_hi(w.z), 0, false); t1 = __builtin_amdgcn_cvt_pk_fp8_f32(bf_lo(w.w), bf_hi(w.w), t1, true);
                o8.x = (unsigned)t0; o8.y = (unsigned)t1;
                *(u32x2*)((unsigned char*)WT + (size_t)drow * ldt + col_off + k0 + 32 * k2 + 8 * gq) = o8; }
            else *(bf16x8*)(WT + (size_t)drow * ldt + col_off + k0 + 32 * k2 + 8 * gq) = ov;
        }
    }
}

__device__ __forceinline__ void p0_prologue(const Args& a, LAS unsigned char* lds) {
    const int tid = threadIdx.x, lane = tid & 63, wave = __builtin_amdgcn_readfirstlane(tid >> 6);
    LAS unsigned char* til = lds + wave * (64 * TP);
    const int gw = blockIdx.x * 8 + wave, NGW = gridDim.x * 8;
    unsigned char* ws = a.ws;
    constexpr int I_IN = (D / 64) * (DIN / 64), I_P = (512 / 64) * (D / 64), I_O = (D / 64) * (D / 64), I_UP = (D / 64) * (DFF / 64), I_DN = (DFF / 64) * (D / 64);
    constexpr int NITEMS = I_IN + 2 * I_P + I_O + I_UP + I_DN;
    for (int it = gw; it < NITEMS; it += NGW) {
        int r = it;
        if (r < I_IN) { p0_item64<true, WG_SH>(a.in[2], DIN, (bf16*)(ws + WS_WIN), D, 0, a.in[1], til, r, lane); continue; } r -= I_IN;
        if (r < I_P) { p0_item64<false, WP_SH>(a.in[9], D, (bf16*)(ws + WS_WP), 1024, 0, nullptr, til, r, lane); continue; } r -= I_P;
        if (r < I_P) { p0_item64<false, WP_SH>(a.in[10], D, (bf16*)(ws + WS_WP), 1024, 512, nullptr, til, r, lane); continue; } r -= I_P;
        if (r < I_O) { p0_item64<false, WOUT_SH>(a.in[11], D, (bf16*)(ws + WS_WOUT), D, 0, nullptr, til, r, lane); continue; } r -= I_O;
        if (r < I_UP) { p0_item64<false>(a.in[13], DFF, (bf16*)(ws + WS_WUP), D, 0, a.in[12], til, r, lane); continue; } r -= I_UP;
        p0_item64<false>(a.in[14], D, (bf16*)(ws + WS_WDN), DFF, 0, nullptr, til, r, lane);
    }
    { f32x2* rt = (f32x2*)(ws + WS_ROPE);
      for (int e = blockIdx.x * 512 + tid; e < SEQ * 64; e += gridDim.x * 512) { const int pos = e >> 6, i = e & 63;
          const float inv = powf(10000.0f, -(float)(2 * i) / 128.0f); const float ang = (float)pos * inv; rt[e] = (f32x2){cosf(ang), sinf(ang)}; } }
    { float* sm = (float*)(ws + WS_SMALL); const int e = blockIdx.x * 512 + tid;
      if (e < 512) sm[e] = a.in[4 + (e >> 7)][e & 127]; else if (e < 512 + 4096) sm[e] = a.in[3][e - 512]; }
    for (int m = (blockIdx.x & 7) * SEQ + (blockIdx.x >> 3) * (SEQ / (NGW / 64)) + wave * (SEQ / (NGW / 8)), mend = m + SEQ / (NGW / 8); m < mend; m += 2) {
        const f32x4* xr = (const f32x4*)(a.in[0] + (size_t)m * D) + lane; f32x4 v[16]; float s0 = 0.f, s1 = 0.f;
#pragma unroll
        for (int j = 0; j < 16; ++j) v[j] = __builtin_nontemporal_load(xr + 64 * j);
#pragma unroll
        for (int j = 0; j < 8; ++j) { s0 += (v[j].x * v[j].x + v[j].y * v[j].y) + (v[j].z * v[j].z + v[j].w * v[j].w);
            s1 += (v[8 + j].x * v[8 + j].x + v[8 + j].y * v[8 + j].y) + (v[8 + j].z * v[8 + j].z + v[8 + j].w * v[8 + j].w); }
#pragma unroll
        for (int o = 1; o < 64; o <<= 1) { s0 += __shfl_xor(s0, o); s1 += __shfl_xor(s1, o); }
        const float r0 = rsqrtf(s0 * (1.0f / D) + EPS), r1 = rsqrtf(s1 * (1.0f / D) + EPS);
        unsigned* o4 = (unsigned*)((unsigned char*)a.out + OUT_XN8 + (size_t)m * 2048 + (size_t)(m >> 11) * X_XN8) + lane;
#pragma unroll
        for (int j = 0; j < 16; ++j) { const float rs = j < 8 ? r0 : r1; int t = __builtin_amdgcn_cvt_pk_fp8_f32(v[j].x * rs, v[j].y * rs, 0, false); t = __builtin_amdgcn_cvt_pk_fp8_f32(v[j].z * rs, v[j].w * rs, t, true); o4[64 * j] = (unsigned)t; }
    }
}
typedef f32x4 AccT[2][2][4][2];

struct EpiProj {
    static constexpr bool PERM = true, AFTER_DRAIN = false, MIDK = false, INIT = false;
    unsigned char* ws;
    __device__ __forceinline__ void operator()(const AccT& acc, const pg8::Unit& u, int wr, int wc, int fr, int fq) const {
        const int row0 = u.pm * 256 + wr * 64 + fr, cl = wc * 32 + 8 * fq;
        constexpr float PSC = 1.0f / (float)(1 << WG_SH);
        const size_t bb = (size_t)(u.pm >> 3);
        bf16* const V = (bf16*)(ws + WS_V) + bb * X_QKV; bf16* const G = (bf16*)(ws + WS_G) + bb * X_G; float* const ssq = (float*)(ws + WS_SSQ); const f32x4* const rope = (const f32x4*)(ws + WS_ROPE);
        const float* const small = (const float*)(ws + WS_SMALL); const float* const bgate = small + 512;
        if (u.pn < 16) {
            const bool isk = u.pn >= 8; bf16* O = (bf16*)(ws + (isk ? WS_K : WS_Q)) + bb * X_QKV;
            const int i0 = 16 * wc + 4 * fq;
            const bool dorope = (u.pn & 7) < 6;
            const float* gn = small + (dorope ? 0 : 256) + (isk ? 128 : 0);
            const f32x4 g1 = *(const f32x4*)(gn + i0), g2 = *(const f32x4*)(gn + 64 + i0);
#pragma unroll
            for (int ai = 0; ai < 2; ++ai) {
                f32x4 c01[4], c23[4];
#pragma unroll
                for (int m = 0; m < 4; ++m) { c01[m] = (f32x4){1.f, 0.f, 1.f, 0.f}; c23[m] = c01[m];
                    if (dorope) { const f32x4* rp = rope + ((size_t)((row0 + ai * 128 + m * 16) & (SEQ - 1)) * 64 + i0) / 2; c01[m] = rp[0]; c23[m] = rp[1]; } }
#pragma unroll
                for (int m = 0; m < 4; ++m)
#pragma unroll
                    for (int bj = 0; bj < 2; ++bj) {
                        const int head = (u.pn & 7) * 2 + bj, row = row0 + ai * 128 + m * 16;
                        const f32x4 v0 = acc[ai][bj][m][0] * PSC, v1 = acc[ai][bj][m][1] * PSC;
                        float ss = (v0[0] * v0[0] + v0[1] * v0[1]) + (v0[2] * v0[2] + v0[3] * v0[3]) + (v1[0] * v1[0] + v1[1] * v1[1]) + (v1[2] * v1[2] + v1[3] * v1[3]);
                        ss += __shfl_xor(ss, 16); ss += __shfl_xor(ss, 32);
                        if (fq == 0) ssq[((size_t)row * 32 + (isk ? 16 : 0) + head) * 4 + wc] = ss;
                        float a0 = v0[0] * g1[0], b0 = v0[1] * g2[0], a1 = v0[2] * g1[1], b1 = v0[3] * g2[1];
                        float a2 = v1[0] * g1[2], b2 = v1[1] * g2[2], a3 = v1[2] * g1[3], b3 = v1[3] * g2[3];
                        { float t;
                            t = a0 * c01[m][0] - b0 * c01[m][1]; b0 = b0 * c01[m][0] + a0 * c01[m][1]; a0 = t;
                            t = a1 * c01[m][2] - b1 * c01[m][3]; b1 = b1 * c01[m][2] + a1 * c01[m][3]; a1 = t;
                            t = a2 * c23[m][0] - b2 * c23[m][1]; b2 = b2 * c23[m][0] + a2 * c23[m][1]; a2 = t;
                            t = a3 * c23[m][2] - b3 * c23[m][3]; b3 = b3 * c23[m][2] + a3 * c23[m][3]; a3 = t; }
                        u32x4 w; w.x = cvt_pk_bf16(a0, b0); w.y = cvt_pk_bf16(a1, b1); w.z = cvt_pk_bf16(a2, b2); w.w = cvt_pk_bf16(a3, b3);
                        *(u32x4*)(O + (size_t)row * D + head * 128 + cl) = w;
                    }
            }
        } else if (u.pn < 24) {
#pragma unroll
            for (int ai = 0; ai < 2; ++ai)
#pragma unroll
                for (int m = 0; m < 4; ++m) { bf16* rowp = V + (size_t)(row0 + ai * 128 + m * 16) * D + (u.pn - 16) * 256 + cl;
#pragma unroll
                    for (int bj = 0; bj < 2; ++bj) { const f32x4 v0 = acc[ai][bj][m][0] * PSC, v1 = acc[ai][bj][m][1] * PSC;
                        u32x4 w; w.x = cvt_pk_bf16(v0[0], v0[1]); w.y = cvt_pk_bf16(v0[2], v0[3]); w.z = cvt_pk_bf16(v1[0], v1[1]); w.w = cvt_pk_bf16(v1[2], v1[3]);
                        *(u32x4*)(rowp + bj * 128) = w; } }
        } else {
            const int gc0 = (u.pn - 24) * 256 + cl;
            unsigned char* const G8 = (unsigned char*)(ws + WS_G) + bb * X_G8;
            f32x4 bv[2][2];
#pragma unroll
            for (int bj = 0; bj < 2; ++bj)
#pragma unroll
                for (int n = 0; n < 2; ++n) bv[bj][n] = *(const f32x4*)(bgate + gc0 + bj * 128 + 4 * n) * (-1.4426950408889634f) - 7.994353436858858f;
#pragma unroll
            for (int ai = 0; ai < 2; ++ai)
#pragma unroll
                for (int m = 0; m < 4; ++m) { unsigned char* rowp = G8 + (size_t)(row0 + ai * 128 + m * 16) * 4096 + gc0;
#pragma unroll
                    for (int bj = 0; bj < 2; ++bj) { f32x4 v0 = acc[ai][bj][m][0] * (-1.4426950408889634f * PSC) + bv[bj][0], v1 = acc[ai][bj][m][1] * (-1.4426950408889634f * PSC) + bv[bj][1];
#pragma unroll
                        for (int j = 0; j < 4; ++j) { v0[j] = __builtin_amdgcn_rcpf(__builtin_amdgcn_exp2f(v0[j]) + (1.0f / 255.0f)); v1[j] = __builtin_amdgcn_rcpf(__builtin_amdgcn_exp2f(v1[j]) + (1.0f / 255.0f)); }
                        u32x2 w8; w8.x = 0u; w8.y = 0u;
                        w8.x = __builtin_amdgcn_cvt_pk_u8_f32(v0[0], 0, w8.x); w8.x = __builtin_amdgcn_cvt_pk_u8_f32(v0[1], 1, w8.x); w8.x = __builtin_amdgcn_cvt_pk_u8_f32(v0[2], 2, w8.x); w8.x = __builtin_amdgcn_cvt_pk_u8_f32(v0[3], 3, w8.x);
                        w8.y = __builtin_amdgcn_cvt_pk_u8_f32(v1[0], 0, w8.y); w8.y = __builtin_amdgcn_cvt_pk_u8_f32(v1[1], 1, w8.y); w8.y = __builtin_amdgcn_cvt_pk_u8_f32(v1[2], 2, w8.y); w8.y = __builtin_amdgcn_cvt_pk_u8_f32(v1[3], 3, w8.y);
                        __builtin_nontemporal_store(w8, (u32x2*)(rowp + bj * 128)); } }
        }
    }
};

struct EpiGate {
    static constexpr bool PERM = true, AFTER_DRAIN = false, MIDK = false, INIT = false;
    unsigned char* ws;
    __device__ __forceinline__ void operator()(const AccT& acc, const pg8::Unit& u, int wr, int wc, int fr, int fq) const {
        const int row0 = u.pm * 256 + wr * 64 + fr, gc0 = u.pn * 256 + wc * 32 + 8 * fq;
        bf16* const G = (bf16*)(ws + WS_G) + (size_t)(u.pm >> 3) * X_G; const float* const bgate = (const float*)(ws + WS_SMALL) + 512;
        constexpr float SC = 1.0f / (float)(1 << WG_SH);
        f32x4 bv[2][2];
#pragma unroll
        for (int bj = 0; bj < 2; ++bj)
#pragma unroll
            for (int n = 0; n < 2; ++n) bv[bj][n] = *(const f32x4*)(bgate + gc0 + bj * 128 + 4 * n);
#pragma unroll
        for (int ai = 0; ai < 2; ++ai)
#pragma unroll
            for (int m = 0; m < 4; ++m) { bf16* rowp = G + (size_t)(row0 + ai * 128 + m * 16) * 4096 + gc0;
#pragma unroll
                for (int bj = 0; bj < 2; ++bj) { f32x4 v0 = acc[ai][bj][m][0] * SC + bv[bj][0], v1 = acc[ai][bj][m][1] * SC + bv[bj][1];
#pragma unroll
                    for (int j = 0; j < 4; ++j) { v0[j] = __builtin_amdgcn_rcpf(1.0f + __expf(-v0[j])); v1[j] = __builtin_amdgcn_rcpf(1.0f + __expf(-v1[j])); }
                    u32x4 w; w.x = cvt_pk_bf16(v0[0], v0[1]); w.y = cvt_pk_bf16(v0[2], v0[3]); w.z = cvt_pk_bf16(v1[0], v1[1]); w.w = cvt_pk_bf16(v1[2], v1[3]);
                    __builtin_nontemporal_store(w, (u32x4*)(rowp + bj * 128)); } }
    }
};

__device__ __forceinline__ float ub(unsigned w, int i) { return (float)((w >> (8 * i)) & 0xffu); }
struct EpiMix {
    static constexpr bool PERM = true, AFTER_DRAIN = false, MIDK = true, INIT = false;
    const unsigned char* G; bf16* O;
    __device__ __forceinline__ void mid(AccT& acc, const pg8::Unit& u, int wr, int wc, int fr, int fq) const {
        const int row0 = u.pm * 256 + wr * 64 + fr, col0 = u.pn * 256 + wc * 32 + 8 * fq;
#pragma unroll
        for (int ai = 0; ai < 2; ++ai) {
            u32x2 ga[4][2], gb[4][2];
#pragma unroll
            for (int m = 0; m < 4; ++m) { unsigned goff = (unsigned)(row0 + ai * 128 + m * 16) * 4096u + (unsigned)col0; asm volatile("" : "+v"(goff)); const unsigned char* gp = G + (size_t)(u.pm >> 3) * X_G8 + goff;
#pragma unroll
                for (int bj = 0; bj < 2; ++bj) { ga[m][bj] = *(const u32x2*)(gp + bj * 128); gb[m][bj] = *(const u32x2*)(gp + 2048 + bj * 128); } }
#pragma unroll
            for (int m = 0; m < 4; ++m)
#pragma unroll
                for (int bj = 0; bj < 2; ++bj) { const u32x2 a = ga[m][bj], b = gb[m][bj]; f32x4& v0 = acc[ai][bj][m][0]; f32x4& v1 = acc[ai][bj][m][1];
#pragma unroll
                    for (int i = 0; i < 4; ++i) { v0[i] *= ub(a.x, i) * __builtin_amdgcn_rcpf(fmaxf(ub(b.x, i), 1.0f)); v1[i] *= ub(a.y, i) * __builtin_amdgcn_rcpf(fmaxf(ub(b.y, i), 1.0f)); } }
            asm volatile("" ::: "memory");
        }
    }
    __device__ __forceinline__ void operator()(const AccT& acc, const pg8::Unit& u, int wr, int wc, int fr, int fq) const {
        const int row0 = u.pm * 256 + wr * 64 + fr, col0 = u.pn * 256 + wc * 32 + 8 * fq;
#pragma unroll
        for (int ai = 0; ai < 2; ++ai) {
            u32x2 gb[4][2];
#pragma unroll
            for (int m = 0; m < 4; ++m)
#pragma unroll
                for (int bj = 0; bj < 2; ++bj) gb[m][bj] = *(const u32x2*)(G + (size_t)(u.pm >> 3) * X_G8 + (size_t)(row0 + ai * 128 + m * 16) * 4096 + 2048 + col0 + bj * 128);
#pragma unroll
            for (int m = 0; m < 4; ++m) { const size_t r = (size_t)(row0 + ai * 128 + m * 16);
#pragma unroll
                for (int bj = 0; bj < 2; ++bj) { const u32x2 b = gb[m][bj]; const f32x4 v0 = acc[ai][bj][m][0], v1 = acc[ai][bj][m][1];
                    constexpr float MS = (float)(1 << MIX_SH) / ((float)(1 << (WP_SH + OAB_SH)) * 255.0f);
                    float g[8];
#pragma unroll
                    for (int i = 0; i < 4; ++i) { g[i] = fmaxf(ub(b.x, i), 1.0f) * MS; g[4 + i] = fmaxf(ub(b.y, i), 1.0f) * MS; }
                    int t0 = __builtin_amdgcn_cvt_pk_fp8_f32(v0[0] * g[0], v0[1] * g[1], 0, false); t0 = __builtin_amdgcn_cvt_pk_fp8_f32(v0[2] * g[2], v0[3] * g[3], t0, true);
                    int t1 = __builtin_amdgcn_cvt_pk_fp8_f32(v1[0] * g[4], v1[1] * g[5], 0, false); t1 = __builtin_amdgcn_cvt_pk_fp8_f32(v1[2] * g[6], v1[3] * g[7], t1, true);
                    u32x2 w8; w8.x = (unsigned)t0; w8.y = (unsigned)t1;
                    *(u32x2*)((unsigned char*)O + (size_t)(u.pm >> 3) * X_MIX8 + r * 2048 + col0 + bj * 128) = w8; } }
            asm volatile("" ::: "memory");
        }
    }
};

struct EpiRes1 {
    static constexpr bool PERM = false, AFTER_DRAIN = false, MIDK = false, INIT = true;
    const float* X; float* out; bf16* hb; float* hp;
    __device__ __forceinline__ void init(AccT& acc, const pg8::Unit& u, int wr, int wc, int fr, int fq) const {
        const int row0 = u.pm * 256 + wr * 64 + fr, col0 = u.pn * 256 + wc * 32 + 4 * fq;
#pragma unroll
        for (int ai = 0; ai < 2; ++ai)
#pragma unroll
            for (int m = 0; m < 4; ++m)
#pragma unroll
                for (int bj = 0; bj < 2; ++bj)
#pragma unroll
                    for (int n = 0; n < 2; ++n) acc[ai][bj][m][n] = __builtin_nontemporal_load((const f32x4*)(X + (size_t)(row0 + ai * 128 + m * 16) * D + col0 + bj * 128 + n * 16)) * (float)(1 << (WOUT_SH + MIX_SH));
    }
    __device__ __forceinline__ void operator()(const AccT& acc, const pg8::Unit& u, int wr, int wc, int fr, int fq) const {
        const int row0 = u.pm * 256 + wr * 64 + fr, col0 = u.pn * 256 + wc * 32 + 4 * fq;
#pragma unroll
        for (int ai = 0; ai < 2; ++ai)
#pragma unroll
            for (int m = 0; m < 4; ++m) { const size_t r = (size_t)(row0 + ai * 128 + m * 16); float ss = 0.f;
#pragma unroll
                for (int bj = 0; bj < 2; ++bj)
#pragma unroll
                    for (int n = 0; n < 2; ++n) { const size_t off = r * D + col0 + bj * 128 + n * 16;
                        const f32x4 h = acc[ai][bj][m][n] * (1.0f / (float)(1 << (WOUT_SH + MIX_SH)));
                        ss += (h[0] * h[0] + h[1] * h[1]) + (h[2] * h[2] + h[3] * h[3]);
                        u32x2 w; w.x = cvt_pk_bf16(h[0], h[1]); w.y = cvt_pk_bf16(h[2], h[3]); *(u32x2*)(hb + (size_t)(u.pm >> 3) * X_QKV + off) = w; }
                ss += __shfl_xor(ss, 16); ss += __shfl_xor(ss, 32);
                if (fq == 0) hp[r * 32 + u.pn * 4 + wc] = ss; }
    }
};

struct EpiUp {
    static constexpr bool PERM = true, AFTER_DRAIN = false, MIDK = false, INIT = false;
    const LAS float* rs; bf16* U;
    __device__ __forceinline__ void operator()(const AccT& acc, const pg8::Unit& u, int wr, int wc, int fr, int fq) const {
        const int lr0 = wr * 64 + fr, col0 = u.pn * 256 + wc * 32 + 8 * fq;
#pragma unroll
        for (int ai = 0; ai < 2; ++ai)
#pragma unroll
            for (int m = 0; m < 4; ++m) { const int lr = lr0 + ai * 128 + m * 16; const size_t r = (size_t)(u.pm * 256 + lr);
                const float s = rs[u.idx * 256 + lr];
#pragma unroll
                for (int bj = 0; bj < 2; ++bj) { f32x4 v0 = acc[ai][bj][m][0] * s, v1 = acc[ai][bj][m][1] * s;
#pragma unroll
                    for (int j = 0; j < 4; ++j) { const float a = fmaxf(v0[j], 0.f), b = fmaxf(v1[j], 0.f); v0[j] = a * a; v1[j] = b * b; }
                    u32x4 w; w.x = cvt_pk_bf16(v0[0], v0[1]); w.y = cvt_pk_bf16(v0[2], v0[3]); w.z = cvt_pk_bf16(v1[0], v1[1]); w.w = cvt_pk_bf16(v1[2], v1[3]);
                    __builtin_nontemporal_store(w, (u32x4*)(U + (size_t)(u.pm >> 3) * X_U + r * DFF + col0 + bj * 128)); } }
    }
};

struct EpiRes2 {
    static constexpr bool PERM = false, AFTER_DRAIN = false, MIDK = false, INIT = true;
    float* out; const bf16* hb;
    __device__ __forceinline__ void init(AccT& acc, const pg8::Unit& u, int wr, int wc, int fr, int fq) const {
        const int row0 = u.pm * 256 + wr * 64 + fr, col0 = u.pn * 256 + wc * 32 + 4 * fq;
        const bf16* hbb = hb + (size_t)(u.pm >> 3) * X_QKV;
#pragma unroll
        for (int ai = 0; ai < 2; ++ai)
#pragma unroll
            for (int m = 0; m < 4; ++m)
#pragma unroll
                for (int bj = 0; bj < 2; ++bj)
#pragma unroll
                    for (int n = 0; n < 2; ++n) { const u32x2 w = *(const u32x2*)(hbb + (size_t)(row0 + ai * 128 + m * 16) * D + col0 + bj * 128 + n * 16);
                        acc[ai][bj][m][n] = (f32x4){bf_lo(w.x), bf_hi(w.x), bf_lo(w.y), bf_hi(w.y)}; }
    }
    __device__ __forceinline__ void operator()(const AccT& acc, const pg8::Unit& u, int wr, int wc, int fr, int fq) const {
        const int row0 = u.pm * 256 + wr * 64 + fr, col0 = u.pn * 256 + wc * 32 + 4 * fq;
#pragma unroll
        for (int ai = 0; ai < 2; ++ai)
#pragma unroll
            for (int m = 0; m < 4; ++m) { const size_t r = (size_t)(row0 + ai * 128 + m * 16);
#pragma unroll
                for (int bj = 0; bj < 2; ++bj)
#pragma unroll
                    for (int n = 0; n < 2; ++n) __builtin_nontemporal_store(acc[ai][bj][m][n], (f32x4*)(out + r * D + col0 + bj * 128 + n * 16)); }
    }
};
#define MFMA16(a, b, c) __builtin_amdgcn_mfma_f32_16x16x32_bf16((a), (b), (c), 0, 0, 0)
__device__ __forceinline__ bf16x8 tr_pair(LAS unsigned char* p0, LAS unsigned char* p1) {
    const s16x4 lo = __builtin_amdgcn_ds_read_tr16_b64_v4i16((LAS s16x4*)p0), hi = __builtin_amdgcn_ds_read_tr16_b64_v4i16((LAS s16x4*)p1);
    return __builtin_shufflevector(lo, hi, 0, 1, 2, 3, 4, 5, 6, 7);
}
__device__ __forceinline__ bf16x8 pack_p(const f32x4& a, const f32x4& b) {
    u32x4 w; w.x = cvt_pk_bf16(a[0], a[1]); w.y = cvt_pk_bf16(a[2], a[3]); w.z = cvt_pk_bf16(b[0], b[1]); w.w = cvt_pk_bf16(b[2], b[3]);
    return __builtin_bit_cast(bf16x8, w);
}
struct QPre { bf16x8 q[4]; f32x4 sq, sk; };
struct AttnPtrs { const bf16 *Q, *K, *V; const float* ssq; bf16* og; float* lse; bf16* oab; const float* rpb; };


__device__ __forceinline__ void attn_issue_loads(const AttnPtrs& P, int unit, u32x4 (&pf)[16], QPre& qp, int tid) {
    const int lane_ = tid & 63, w_ = tid >> 6, j_ = lane_ & 15, g4_ = lane_ >> 4;
    if (unit < 1536) {
        const int bh = unit >> 4, idx = unit & 15, b = bh / 12, h = bh % 12, sh = 2 * (h >> 2), M = SEQ >> sh, lg = 4 - sh;
        const int qb = idx & ((1 << lg) - 1), r = idx >> lg, kstart = 128 * qb - 64;
#pragma unroll
        for (int p = 0; p < 8; ++p) { const int row = p * 32 + (tid >> 4), ch = tid & 15, m = kstart + row;
            pf[p] = (u32x4){0u, 0u, 0u, 0u}; pf[8 + p] = pf[p];
            if (m >= 0 && m < M) { const size_t off = (size_t)b * X_QKV + ((size_t)b * SEQ + ((size_t)m << sh) + r) * D + h * 128 + ch * 8; pf[p] = *(const u32x4*)(P.K + off); pf[8 + p] = *(const u32x4*)(P.V + off); } }
        { const size_t tokq = (size_t)b * SEQ + ((size_t)(128 * qb + 16 * w_ + j_) << sh) + r;
#pragma unroll
          for (int s = 0; s < 4; ++s) qp.q[s] = *(const bf16x8*)(P.Q + (size_t)b * X_QKV + tokq * D + h * 128 + 32 * s + 8 * g4_);
          qp.sq = *(const f32x4*)(P.ssq + (tokq * 32 + h) * 4);
          const int mk = kstart + (tid & 255); qp.sk = (f32x4){0.f, 0.f, 0.f, 0.f};
          if (mk >= 0 && mk < M) qp.sk = *(const f32x4*)(P.ssq + (((size_t)b * SEQ + ((size_t)mk << sh) + r) * 32 + 16 + h) * 4); }
    } else {
        const int ub = unit - 1536, b = ub >> 7, hB = (ub >> 5) & 3, r = ub & 31, rs = min(max(r - 4, 0), 24);
        const size_t tok0 = (size_t)b * SEQ + rs * 64;
#pragma unroll
        for (int p = 0; p < 16; ++p) { const int row = p * 32 + (tid >> 4), ch = tid & 15; pf[p] = *(const u32x4*)(P.K + (size_t)b * X_QKV + (tok0 + row) * D + (12 + hB) * 128 + ch * 8); }
    }
}

__device__ __forceinline__ void attnB_issue_k(const AttnPtrs& P, int ub, u32x4 (&pf)[16], int tid) {
    const int b = ub >> 7, hB = (ub >> 5) & 3, r = ub & 31, rs = min(max(r - 4, 0), 24);
    const size_t tok0 = (size_t)b * SEQ + rs * 64;
#pragma unroll
    for (int p = 0; p < 16; ++p) { const int row = p * 32 + (tid >> 4), ch = tid & 15; pf[p] = *(const u32x4*)(P.K + (size_t)b * X_QKV + (tok0 + row) * D + (12 + hB) * 128 + ch * 8); }
}

__device__ __forceinline__ void attnA_unit(const AttnPtrs& P, LAS unsigned char* lds, int unit, int next_unit, u32x4 (&pf)[16], QPre& qp) {
    const int tid = threadIdx.x, lane = tid & 63, w = __builtin_amdgcn_readfirstlane(tid >> 6), j = lane & 15, g4 = lane >> 4;
    const int bh = unit >> 4, idx = unit & 15, b = bh / 12, h = bh % 12, grp = h >> 2, sh = 2 * grp, M = SEQ >> sh, lg = 4 - sh;
    const int qb = idx & ((1 << lg) - 1), r = idx >> lg, kstart = 128 * qb - 64;
    LAS unsigned char* ldsK = lds + LDS_KV; LAS unsigned char* ldsV = lds + LDS_KV + 256 * KP; LAS float* sk = (LAS float*)(lds + LDS_SK);
    __syncthreads();
#pragma unroll
    for (int p = 0; p < 8; ++p) { const int row = p * 32 + (tid >> 4), ch = tid & 15; *(LAS u32x4*)(ldsK + row * KP + ch * 16) = pf[p]; *(LAS u32x4*)(ldsV + row * KP + ch * 16) = pf[8 + p]; }
    if (tid < 256) { const f32x4 p = qp.sk; sk[tid] = rsqrtf(((p[0] + p[1]) + (p[2] + p[3])) * (1.0f / 128.0f) + EPS); }
    const int qi = 16 * w + j; const size_t tokq = (size_t)b * SEQ + ((size_t)(128 * qb + qi) << sh) + r;
    bf16x8 qf[4];
#pragma unroll
    for (int s = 0; s < 4; ++s) qf[s] = qp.q[s];
    float sq; { const f32x4 p = qp.sq; sq = rsqrtf(((p[0] + p[1]) + (p[2] + p[3])) * (1.0f / 128.0f) + EPS) * 0.08838834764831845f; }
    __syncthreads();
    if (next_unit >= 0) attn_issue_loads(P, next_unit, pf, qp, tid);
    f32x4 S[9];
#pragma unroll
    for (int i = 0; i < 9; ++i) S[i] = (f32x4){0.f, 0.f, 0.f, 0.f};
    {
        const LAS unsigned char* kb0 = ldsK + (16 * w + j) * KP + 16 * g4;
#pragma unroll
        for (int s = 0; s < 4; ++s) {
            bf16x8 kf[9];
#pragma unroll
            for (int i = 0; i < 9; ++i) kf[i] = *(const LAS bf16x8*)(kb0 + 16 * i * KP + 64 * s);
            __builtin_amdgcn_sched_barrier(0);
#pragma unroll
            for (int i = 0; i < 9; ++i) S[i] = MFMA16(kf[i], qf[s], S[i]);
            __builtin_amdgcn_sched_barrier(0);
        }
    }
    float mx = -1e30f;
    const int tlo = max(j, -(kstart + 16 * w)), trange = min(j + 128, M - 1 - kstart - 16 * w) - tlo, tb4 = 4 * g4 - tlo;
    const float sq2 = sq * 1.4426950408889634f;
#pragma unroll
    for (int i = 0; i < 9; ++i) { const f32x4 skv = *(const LAS f32x4*)(sk + 16 * (w + i) + 4 * g4);
#pragma unroll
        for (int e = 0; e < 4; ++e) { const bool ok = (unsigned)(tb4 + 16 * i + e) <= (unsigned)trange;
            S[i][e] = ok ? S[i][e] * skv[e] * sq2 : -1e30f; mx = fmaxf(mx, S[i][e]); } }
    mx = fmaxf(mx, __shfl_xor(mx, 16)); mx = fmaxf(mx, __shfl_xor(mx, 32));
    float sum = 0.f;
#pragma unroll
    for (int i = 0; i < 9; ++i)
#pragma unroll
        for (int e = 0; e < 4; ++e) { S[i][e] = __builtin_amdgcn_exp2f(S[i][e] - mx); sum += S[i][e]; }
    sum += __shfl_xor(sum, 16); sum += __shfl_xor(sum, 32);
    f32x4 o[8];
#pragma unroll
    for (int c = 0; c < 8; ++c) o[c] = (f32x4){0.f, 0.f, 0.f, 0.f};
    const f32x4 zero4 = (f32x4){0.f, 0.f, 0.f, 0.f};
    {   LAS unsigned char* vb0 = ldsV + (16 * w + 4 * g4 + (j >> 2)) * KP + 8 * (j & 3);
#pragma unroll
        for (int pp = 0; pp < 5; ++pp) { const int ta = 2 * pp, tb = (pp < 4) ? ta + 1 : 8;
            bf16x8 vf[8];
#pragma unroll
            for (int c = 0; c < 8; ++c) vf[c] = tr_pair(vb0 + 16 * ta * KP + 32 * c, vb0 + 16 * tb * KP + 32 * c);
            const bf16x8 pf = pack_p(S[ta], (pp < 4) ? S[tb] : zero4);
            __builtin_amdgcn_sched_barrier(0);
#pragma unroll
            for (int c = 0; c < 8; ++c) o[c] = MFMA16(vf[c], pf, o[c]);
            __builtin_amdgcn_sched_barrier(0);
        }
    }
    const float inv = 1.0f / sum;
    bf16* op = P.og + (size_t)b * X_OG + (tokq * 12 + h) * 128 + 4 * g4;
#pragma unroll
    for (int c = 0; c < 8; ++c) { u32x2 wv; wv.x = cvt_pk_bf16(o[c][0] * inv, o[c][1] * inv); wv.y = cvt_pk_bf16(o[c][2] * inv, o[c][3] * inv); *(u32x2*)(op + 16 * c) = wv; }
    if (g4 == 0) P.lse[tokq * 12 + h] = mx * 0.6931471805599453f + __logf(sum);
}

__device__ __forceinline__ void attnB_unit(const AttnPtrs& P, LAS unsigned char* lds, int unit, int next_unit, u32x4 (&pf)[16], QPre& qp) {
    const int tid = threadIdx.x, lane = tid & 63, w = __builtin_amdgcn_readfirstlane(tid >> 6), j = lane & 15, g4 = lane >> 4;
    const int b = unit >> 7, hB = (unit >> 5) & 3, r = unit & 31, head = 12 + hB;
    const int rs = min(max(r - 4, 0), 24);
    const size_t tok0 = (size_t)b * SEQ + rs * 64;
    LAS unsigned char* kvb = lds + LDS_KV; LAS float* sk = (LAS float*)(lds + LDS_SK); LAS float* rpbL = (LAS float*)(lds + LDS_RPB);
    const int cb = w & 3, dh = w >> 2, qc = 16 * cb + j; const size_t tokq = (size_t)b * SEQ + r * 64 + qc;
    bf16x8 qf[4];
#pragma unroll
    for (int s = 0; s < 4; ++s) qf[s] = *(const bf16x8*)(P.Q + (size_t)b * X_QKV + tokq * D + head * 128 + 32 * s + 8 * g4);
    const f32x4 psq = *(const f32x4*)(P.ssq + (tokq * 32 + head) * 4), psk = *(const f32x4*)(P.ssq + ((tok0 + tid) * 32 + 16 + head) * 4);
    __syncthreads();
#pragma unroll
    for (int p = 0; p < 16; ++p) { const int row = p * 32 + (tid >> 4), ch = tid & 15; *(LAS u32x4*)(kvb + row * KP + ch * 16) = pf[p]; }
    { const f32x4 p = psk; sk[tid] = rsqrtf(((p[0] + p[1]) + (p[2] + p[3])) * (1.0f / 128.0f) + EPS); }
    if (tid < 465) rpbL[tid] = P.rpb[hB * 465 + tid] * 1.4426950408889634f;
    float sq; { const f32x4 p = psq; sq = rsqrtf(((p[0] + p[1]) + (p[2] + p[3])) * (1.0f / 128.0f) + EPS) * 0.08838834764831845f; }
    __syncthreads();
    const int cbase = cb == 0 ? 0 : (cb == 1 ? 8 : (cb == 2 ? 24 : 32)), cs = min(max(qc - 8, 0), 48);
    f32x4 S[16];
#pragma unroll
    for (int tt = 0; tt < 16; ++tt) S[tt] = (f32x4){0.f, 0.f, 0.f, 0.f};
    {
        const LAS unsigned char* kb0 = kvb + (cbase + j) * KP + 16 * g4;
#pragma unroll
        for (int q = 0; q < 8; ++q) { const int s = q >> 1, hf = q & 1;
            bf16x8 kf[8];
#pragma unroll
            for (int t = 0; t < 8; ++t) { const int tt = 8 * hf + t; kf[t] = *(const LAS bf16x8*)(kb0 + ((tt >> 1) * 64 + 16 * (tt & 1)) * KP + 64 * s); }
            __builtin_amdgcn_sched_barrier(0);
#pragma unroll
            for (int t = 0; t < 8; ++t) S[8 * hf + t] = MFMA16(kf[t], qf[s], S[8 * hf + t]);
            __builtin_amdgcn_sched_barrier(0);
        }
    }
    __builtin_amdgcn_sched_barrier(0);
#pragma unroll
    for (int p = 0; p < 16; ++p) { const int row = p * 32 + (tid >> 4), ch = tid & 15; pf[p] = *(const u32x4*)(P.V + (size_t)b * X_QKV + (tok0 + row) * D + head * 128 + ch * 8); }
    __builtin_amdgcn_sched_barrier(0);
    float mx = -1e30f;
    const float sq2 = sq * 1.4426950408889634f;
    const int kb4 = cbase + 4 * g4 - cs;
    const LAS float* bl = rpbL + (rs - r + 7) * 31 + (cbase + 4 * g4 - qc + 15);
#pragma unroll
    for (int tt = 0; tt < 16; ++tt) { const int kr = tt >> 1, ct = tt & 1; const f32x4 skv = *(const LAS f32x4*)(sk + kr * 64 + cbase + 16 * ct + 4 * g4);
        float bv[4];
#pragma unroll
        for (int e = 0; e < 4; ++e) bv[e] = bl[kr * 31 + 16 * ct + e];
#pragma unroll
        for (int e = 0; e < 4; ++e) { const bool ok = (unsigned)(kb4 + 16 * ct + e) < 16u;
            const float sv = S[tt][e] * skv[e] * sq2 + bv[e];
            S[tt][e] = ok ? sv : -1e30f; mx = fmaxf(mx, S[tt][e]); } }
    mx = fmaxf(mx, __shfl_xor(mx, 16)); mx = fmaxf(mx, __shfl_xor(mx, 32));
    float sum = 0.f;
#pragma unroll
    for (int tt = 0; tt < 16; ++tt)
#pragma unroll
        for (int e = 0; e < 4; ++e) { S[tt][e] = __builtin_amdgcn_exp2f(S[tt][e] - mx); sum += S[tt][e]; }
    sum += __shfl_xor(sum, 16); sum += __shfl_xor(sum, 32);
    __syncthreads();
#pragma unroll
    for (int p = 0; p < 16; ++p) { const int row = p * 32 + (tid >> 4), ch = tid & 15; *(LAS u32x4*)(kvb + row * KP + ch * 16) = pf[p]; }
    if (next_unit >= 0) attnB_issue_k(P, next_unit - 1536, pf, tid);
    __syncthreads();
    f32x4 o[4];
#pragma unroll
    for (int c = 0; c < 4; ++c) o[c] = (f32x4){0.f, 0.f, 0.f, 0.f};
    {   LAS unsigned char* vb0 = kvb + (cbase + 4 * g4 + (j >> 2)) * KP + 128 * dh + 8 * (j & 3);
#pragma unroll
        for (int q = 0; q < 4; ++q) {
            bf16x8 vf[8];
#pragma unroll
            for (int t = 0; t < 8; ++t) { const int pr = 2 * q + (t >> 2); vf[t] = tr_pair(vb0 + 64 * pr * KP + 32 * (t & 3), vb0 + (64 * pr + 16) * KP + 32 * (t & 3)); }
            const bf16x8 p0 = pack_p(S[4 * q], S[4 * q + 1]), p1 = pack_p(S[4 * q + 2], S[4 * q + 3]);
            __builtin_amdgcn_sched_barrier(0);
#pragma unroll
            for (int t = 0; t < 8; ++t) o[t & 3] = MFMA16(vf[t], (t >> 2) ? p1 : p0, o[t & 3]);
            __builtin_amdgcn_sched_barrier(0);
        }
    }
    const float inv = 1.0f / sum;
    const float inv8 = inv * (float)(1 << OAB_SH);
    unsigned char* op = (unsigned char*)P.oab + (size_t)b * X_OAB8 + tokq * 1024 + 512 + hB * 128 + 64 * dh + 4 * g4;
#pragma unroll
    for (int c = 0; c < 4; ++c) { int t = __builtin_amdgcn_cvt_pk_fp8_f32(o[c][0] * inv8, o[c][1] * inv8, 0, false); t = __builtin_amdgcn_cvt_pk_fp8_f32(o[c][2] * inv8, o[c][3] * inv8, t, true); *(unsigned*)(op + 16 * c) = (unsigned)t; }
}

__device__ __forceinline__ void combine_phase(const AttnPtrs& P) {
    const int tid = threadIdx.x, lane = tid & 63, wave = tid >> 6, gw = blockIdx.x * 8 + wave, NGW = gridDim.x * 8;
    const int slot = lane >> 4, d8 = (lane & 15) * 8;
    for (int tok = (blockIdx.x & 7) * SEQ + (blockIdx.x >> 3) * (SEQ / (NGW / 64)) + wave * (SEQ / (NGW / 8)), tend = tok + SEQ / (NGW / 8); tok < tend; ++tok) {
        const float l0 = P.lse[(size_t)tok * 12 + slot], l1 = P.lse[(size_t)tok * 12 + 4 + slot], l2 = P.lse[(size_t)tok * 12 + 8 + slot];
        const float L = fmaxf(l0, fmaxf(l1, l2)); float w0 = __expf(l0 - L), w1 = __expf(l1 - L), w2 = __expf(l2 - L);
        const float inv = 1.0f / (w0 + w1 + w2); w0 *= inv; w1 *= inv; w2 *= inv;
        const bf16* base = P.og + (size_t)(tok >> 11) * X_OG + ((size_t)tok * 12 + slot) * 128 + d8;
        const u32x4 a = __builtin_nontemporal_load((const u32x4*)base), bq = __builtin_nontemporal_load((const u32x4*)(base + 4 * 128)), c = __builtin_nontemporal_load((const u32x4*)(base + 8 * 128));
        w0 *= (float)(1 << OAB_SH); w1 *= (float)(1 << OAB_SH); w2 *= (float)(1 << OAB_SH);
        int t0 = __builtin_amdgcn_cvt_pk_fp8_f32(w0 * bf_lo(a.x) + w1 * bf_lo(bq.x) + w2 * bf_lo(c.x), w0 * bf_hi(a.x) + w1 * bf_hi(bq.x) + w2 * bf_hi(c.x), 0, false);
        t0 = __builtin_amdgcn_cvt_pk_fp8_f32(w0 * bf_lo(a.y) + w1 * bf_lo(bq.y) + w2 * bf_lo(c.y), w0 * bf_hi(a.y) + w1 * bf_hi(bq.y) + w2 * bf_hi(c.y), t0, true);
        int t1 = __builtin_amdgcn_cvt_pk_fp8_f32(w0 * bf_lo(a.z) + w1 * bf_lo(bq.z) + w2 * bf_lo(c.z), w0 * bf_hi(a.z) + w1 * bf_hi(bq.z) + w2 * bf_hi(c.z), 0, false);
        t1 = __builtin_amdgcn_cvt_pk_fp8_f32(w0 * bf_lo(a.w) + w1 * bf_lo(bq.w) + w2 * bf_lo(c.w), w0 * bf_hi(a.w) + w1 * bf_hi(bq.w) + w2 * bf_hi(c.w), t1, true);
        u32x2 o8; o8.x = (unsigned)t0; o8.y = (unsigned)t1;
        *(u32x2*)((unsigned char*)P.oab + (size_t)(tok >> 11) * X_OAB8 + (size_t)tok * 1024 + slot * 128 + d8) = o8;
    }
}
constexpr int N_PHASES = 8;
__device__ __forceinline__ void grid_bar(unsigned* ctl, unsigned gen) {
    asm volatile("s_waitcnt vmcnt(0)" ::: "memory");
    __syncthreads();
    if (threadIdx.x == 0) {
        const unsigned x = blockIdx.x & 7u, nloc = gridDim.x >> 3;
        unsigned* xsub = ctl + 64 * (1 + x); unsigned* xgen = ctl + 64 * (9 + x); unsigned* top = ctl + 64 * 17; unsigned* topgen = ctl + 64 * 18;
        __builtin_amdgcn_fence(__ATOMIC_RELEASE, "agent");
        asm volatile("s_waitcnt vmcnt(0)" ::: "memory");
        const unsigned old = __hip_atomic_fetch_add(xsub, 1u, __ATOMIC_RELAXED, __HIP_MEMORY_SCOPE_AGENT);
        if (old + 1u == gen * nloc) {
            const unsigned og = __hip_atomic_fetch_add(top, 1u, __ATOMIC_RELAXED, __HIP_MEMORY_SCOPE_AGENT);
            if (og + 1u == gen * 8u) __hip_atomic_store(topgen, gen, __ATOMIC_RELAXED, __HIP_MEMORY_SCOPE_AGENT);
            else while (__hip_atomic_load(topgen, __ATOMIC_RELAXED, __HIP_MEMORY_SCOPE_AGENT) < gen) __builtin_amdgcn_s_sleep(1);
            __hip_atomic_store(xgen, gen, __ATOMIC_RELAXED, __HIP_MEMORY_SCOPE_AGENT);
        } else {
            while (__hip_atomic_load(xgen, __ATOMIC_RELAXED, __HIP_MEMORY_SCOPE_AGENT) < gen) __builtin_amdgcn_s_sleep(1);
        }
        __builtin_amdgcn_fence(__ATOMIC_ACQUIRE, "agent");
        asm volatile("s_waitcnt vmcnt(0)" ::: "memory");
    }
    __syncthreads();
}
__device__ __forceinline__ void group_bar(unsigned* ctl, unsigned gen, bool same_xcd) {
    asm volatile("s_waitcnt vmcnt(0)" ::: "memory");
    __syncthreads();
    if (threadIdx.x == 0) {
        unsigned* cnt = ctl + 64 * (20 + (blockIdx.x & 7u)); const unsigned target = gen * (gridDim.x >> 3);
        if (!same_xcd) { __builtin_amdgcn_fence(__ATOMIC_RELEASE, "agent"); asm volatile("s_waitcnt vmcnt(0)" ::: "memory"); }
        __hip_atomic_fetch_add(cnt, 1u, __ATOMIC_RELAXED, __HIP_MEMORY_SCOPE_AGENT);
        while (__hip_atomic_load(cnt, __ATOMIC_RELAXED, __HIP_MEMORY_SCOPE_AGENT) < target) __builtin_amdgcn_s_sleep(1);
        __builtin_amdgcn_fence(__ATOMIC_ACQUIRE, "agent");
        asm volatile("s_waitcnt vmcnt(0)" ::: "memory");
    }
    __syncthreads();
}
__global__ void __launch_bounds__(512) fwd_megakernel(Args a) {
    __shared__ __attribute__((aligned(16))) unsigned char lds_raw[LDS_BYTES];
    LAS unsigned char* lds = (LAS unsigned char*)lds_raw;
    unsigned char* ws = a.ws; unsigned char* ob = (unsigned char*)a.out;
    const int lo = a.ph_lo, hi = a.ph_hi, G = gridDim.x; int nbar = 0, ngbar = 0; bool same_xcd = false;
#ifdef ONLY
#define IN(k) ((k) == ONLY && lo <= (k) && (k) < hi)
#else
#define IN(k) (lo <= (k) && (k) < hi)
#endif
#if MK_MULTI
#define GSEAM(k) do { } while (0)
#define SEAM(k) do { } while (0)
#else
#define GSEAM(k) do { if (IN(k) && IN((k) + 1)) { group_bar((unsigned*)ws, (unsigned)(++ngbar), same_xcd); } } while (0)
#ifndef BARX
#define BARX 1
#endif
#define SEAM(k) do { if (IN(k) && IN((k) + 1)) { if ((k) == 0) cg::this_grid().sync(); else { for (int bx_ = 0; bx_ < BARX; ++bx_) grid_bar((unsigned*)ws, (unsigned)(++nbar)); } } } while (0)
#endif
    bf16* const Qb = (bf16*)(ws + WS_Q); bf16* const Kb = (bf16*)(ws + WS_K); bf16* const Vb = (bf16*)(ws + WS_V); bf16* const Gb = (bf16*)(ws + WS_G);
    float* const ssq = (float*)(ws + WS_SSQ); float* const hp = (float*)(ws + WS_HP);
    bf16* const oab = (bf16*)(ob + OUT_OAB);

    const int vid = (int)blockIdx.x;
#ifndef DUP
#define DUP -1
#endif
#define REP(k) _Pragma("unroll 1") for (int rep_ = 0; rep_ < ((k) == DUP ? (hi >> 2) : 1); ++rep_)
#if !MK_MULTI
    if (threadIdx.x == 0) __hip_atomic_store((unsigned*)ws + 2048 + blockIdx.x, ((unsigned)__builtin_amdgcn_s_getreg((3 << 11) | 20) & 0xFu) + 1u, __ATOMIC_RELAXED, __HIP_MEMORY_SCOPE_AGENT);
#endif
    if (IN(0)) { if (blockIdx.x == 0) { for (int i = threadIdx.x; i < 2048; i += 512) __hip_atomic_store((unsigned*)ws + i, 0u, __ATOMIC_RELAXED, __HIP_MEMORY_SCOPE_AGENT); }
        REP(0) { p0_prologue(a, lds); __syncthreads(); } }
    SEAM(0);
#if !MK_MULTI
    {
        const int lane_ = threadIdx.x & 63; unsigned v_ = 0u;
        if (lane_ < (G >> 3) && lane_ < 64) v_ = __hip_atomic_load((unsigned*)ws + 2048 + (blockIdx.x & 7u) + 8u * lane_, __ATOMIC_RELAXED, __HIP_MEMORY_SCOPE_AGENT);
        const unsigned ref_ = (unsigned)__builtin_amdgcn_readfirstlane((int)v_);
        const bool eq_ = (lane_ >= (G >> 3)) || (v_ == ref_ && v_ != 0u);
        same_xcd = (G >> 3) <= 64 && __builtin_amdgcn_ballot_w64(eq_) == ~0ull;
    }
#endif
    if (IN(1)) {
        pg8::Gemm g{(const bf16*)(ob + OUT_XN8), (const bf16*)(ws + WS_WIN), T, DIN, D / 2, X_XN8}; pg8::StaticOrder S; S.init(T, DIN, G, vid, DUP == 1);
        EpiProj E{ws};
        pg8::gemm_phase<EpiProj, pg8::StaticOrder, true, true, 0, true>(lds, g, S, E);
    }
    GSEAM(1);
    const AttnPtrs AP{Qb, Kb, Vb, ssq, (bf16*)ob, (float*)(ws + WS_LSE), oab, a.in[8]};
    if (IN(2)) {
        {
            constexpr int RP = (DUP == 2) ? 2 : 1;
            const int nA = 1536 / G, nB = 1024 / G, xq = vid & 7, jq = vid >> 3, perX = G >> 3;
#define UNIT_A(n) (xq * (1536 / 8) + jq + perX * ((n) % nA))
#define UNIT_B(n) (1536 + xq * (1024 / 8) + jq + perX * ((n) % nB))
            u32x4 pf[16]; QPre qp;
            attn_issue_loads(AP, UNIT_A(0), pf, qp, threadIdx.x);
#pragma unroll 1
            for (int n = 0; n < RP * nA; ++n) { const int u = UNIT_A(n), un = (n + 1 < RP * nA) ? UNIT_A(n + 1) : UNIT_B(0); attnA_unit(AP, lds, u, un, pf, qp); }
#pragma unroll 1
            for (int n = 0; n < RP * nB; ++n) { const int u = UNIT_B(n), un = (n + 1 < RP * nB) ? UNIT_B(n + 1) : -1; attnB_unit(AP, lds, u - 1536, un, pf, qp); }
#undef UNIT_A
#undef UNIT_B
            __syncthreads(); }
    }
    GSEAM(2);
    if (IN(3)) { combine_phase(AP); }
    GSEAM(3);
    if (IN(4)) {
        pg8::Gemm g{oab, (const bf16*)(ws + WS_WP), T, D, 512, X_OAB8};     pg8::StaticOrder S; S.init(T, D, G, vid, DUP == 4);
        EpiMix E{(const unsigned char*)(ws + WS_G), Kb};
        pg8::gemm_phase<EpiMix, pg8::StaticOrder, true, true, 0, true>(lds, g, S, E);
    }
    GSEAM(4);
    if (IN(5)) {
        pg8::Gemm g{Kb, (const bf16*)(ws + WS_WOUT), T, D, D / 2, X_MIX8};     pg8::StaticOrder S; S.init(T, D, G, vid, DUP == 5);
        EpiRes1 E{a.in[0], a.out, Qb, hp};
        pg8::gemm_phase<EpiRes1, pg8::StaticOrder, true, true, 0, true>(lds, g, S, E);
    }
    GSEAM(5);
    if (IN(6)) {
        pg8::Gemm g{Qb, (const bf16*)(ws + WS_WUP), T, DFF, D, X_QKV * 2}; pg8::StaticOrder S; S.init(T, DFF, G, vid, DUP == 6);
        LAS float* rsT = (LAS float*)(lds + 131072);
        { pg8::Unit uu; for (int i = 0; S.next(i, uu); ++i) if (threadIdx.x < 256) { const f32x4* pp = (const f32x4*)(hp + (size_t)(uu.pm * 256 + threadIdx.x) * 32); f32x4 s = pp[0];
#pragma unroll
              for (int q = 1; q < 8; ++q) s += pp[q];
              rsT[uu.idx * 256 + threadIdx.x] = rsqrtf(((s[0] + s[1]) + (s[2] + s[3])) * (1.0f / D) + EPS); }
          __syncthreads(); }
        EpiUp E{rsT, (bf16*)(ws + WS_U)};
        pg8::gemm_phase<EpiUp, pg8::StaticOrder, true, true>(lds, g, S, E);
    }
    GSEAM(6);
    if (IN(7)) {
        pg8::Gemm g{(const bf16*)(ws + WS_U), (const bf16*)(ws + WS_WDN), T, D, DFF, X_U * 2}; pg8::StaticOrder S; S.init(T, D, G, vid);
        EpiRes2 E{a.out, Qb};
        pg8::gemm_phase<EpiRes2, pg8::StaticOrder, true, true>(lds, g, S, E);
    }
#undef IN
#undef SEAM
#undef GSEAM
}

extern "C" void kernel_launch(void* const* d_in, const int* in_sizes, int n_in, void* d_out, int out_size, void* d_ws, size_t ws_size, hipStream_t stream) {
    static int grid = 0;
    if (grid == 0) {
        if (n_in != 15 || in_sizes[0] != T * D || out_size != T * D || ws_size < WS_END) { fprintf(stderr, "kernel_launch: unexpected shapes (n_in %d, x %d, out %d, ws %zu)\n", n_in, n_in > 0 ? in_sizes[0] : -1, out_size, ws_size); grid = -1; return; }
        int dev = 0, cus = 0, per_cu = 0;
        hipGetDevice(&dev); hipDeviceGetAttribute(&cus, hipDeviceAttributeMultiprocessorCount, dev);
        hipOccupancyMaxActiveBlocksPerMultiprocessor(&per_cu, (const void*)fwd_megakernel, 512, 0);
        if (per_cu < 1) { fprintf(stderr, "kernel_launch: occupancy query says %d blocks per CU\n", per_cu); per_cu = 1; }
        (void)hipGetLastError();
        grid = cus * per_cu;
        if (grid > 256) grid = 256;
        if (grid != 256) { fprintf(stderr, "kernel_launch: this kernel's unit orders need exactly 256 resident workgroups (got %d)\n", grid); grid = -1; return; }
        fprintf(stderr, "kernel_launch: grid %d (cus %d, per_cu %d)\n", grid, cus, per_cu);
    }
    if (grid < 0) return;
    Args a{};
    for (int i = 0; i < 15; ++i) a.in[i] = (const float*)d_in[i];
    a.out = (float*)d_out; a.ws = (unsigned char*)d_ws;
#if MK_MULTI
    for (int p = 0; p < N_PHASES; ++p) { a.ph_lo = p; a.ph_hi = p + 1; hipLaunchKernelGGL(fwd_megakernel, dim3(grid), dim3(512), 0, stream, a); }
#else
    a.ph_lo = 0; a.ph_hi = N_PHASES;
    void* args[] = {&a};
    hipError_t e = hipLaunchCooperativeKernel((const void*)fwd_megakernel, dim3(grid), dim3(512), args, 0, stream);
    if (e != hipSuccess) fprintf(stderr, "kernel_launch: cooperative launch failed: %s (grid %d)\n", hipGetErrorString(e), grid);
#endif
}
```
